# Optimizing an MI355X kernel written in HIP

```python
import math
import jax, jax.numpy as jnp
from jax import lax
import numpy as np

D_MODEL = 1024
BATCH = 2
SEQ = 8192
DEPTH = 2

HEAD_DIM = 64
A_Q_HEADS = 8
A_KV_HEADS = 2
B_HEADS = 8
B_BRANCHES = ((128, 1), (512, 4), (2048, 16))
C_HEADS = 8
C_V_DIM = 2 * HEAD_DIM
D_FF = ((-(-8 * D_MODEL // 3) + 255) // 256) * 256
GRID_W = 64
ROPE_THETA = 10000.0
Q_BLOCK = 128
EPS = 1e-6

N_EVEN = (DEPTH + 1) // 2
N_ODD = DEPTH // 2

A_Q_W = A_Q_HEADS * HEAD_DIM
A_KV_W = A_KV_HEADS * HEAD_DIM
B_W = B_HEADS * HEAD_DIM
EVEN_SPLITS = tuple(int(v) for v in np.cumsum([A_Q_W, A_KV_W, A_KV_W, B_W, B_W]))
EVEN_IN_W = A_Q_W + 2 * A_KV_W + 3 * B_W
EVEN_OUT_W = A_Q_W + B_W
C_QK_W = C_HEADS * 2 * HEAD_DIM
C_V_W = C_HEADS * C_V_DIM
ODD_SPLITS = (C_QK_W, 2 * C_QK_W)
ODD_IN_W = 2 * C_QK_W + C_V_W
ODD_OUT_W = C_V_W

kernel_name = "hybrid_gqa_dilated_diffattn_encoder"


def rms_norm(x, g):
    xf = x.astype(jnp.float32)
    y = xf * lax.rsqrt(jnp.mean(xf * xf, axis=-1, keepdims=True) + EPS)
    return (y * g.astype(jnp.float32)).astype(x.dtype)


def rope_angles(pos, dim):
    inv = ROPE_THETA ** (-jnp.arange(0, dim, 2, dtype=jnp.float32) / dim)
    return pos.astype(jnp.float32)[:, None] * inv[None, :]


def apply_rope(x, ang):
    cos = jnp.cos(ang)[None, :, None, :]
    sin = jnp.sin(ang)[None, :, None, :]
    x1, x2 = jnp.split(x.astype(jnp.float32), 2, axis=-1)
    out = jnp.concatenate([x1 * cos - x2 * sin, x1 * sin + x2 * cos], axis=-1)
    return out.astype(x.dtype)


def gqa_attention(q, k, v):
    bn, s, hq, d = q.shape
    hkv = k.shape[2]
    g = hq // hkv
    nb = s // Q_BLOCK
    scale = d ** -0.5
    qb = q.reshape(bn, nb, Q_BLOCK, hkv, g, d).transpose(1, 0, 2, 3, 4, 5)

    def block(qblk):
        sc = jnp.einsum('bqkgd,bskd->bkgqs', qblk, k).astype(jnp.float32) * scale
        p = jax.nn.softmax(sc, axis=-1).astype(v.dtype)
        return jnp.einsum('bkgqs,bskd->bqkgd', p, v)

    o = lax.map(block, qb)
    return o.transpose(1, 0, 2, 3, 4, 5).reshape(bn, s, hq * d)


def dilated_attention(q, k, v):
    bn, s, h, d = q.shape
    nb = s // Q_BLOCK
    scale = d ** -0.5
    neg = jnp.finfo(jnp.float32).min

    def block(b_idx):
        start = b_idx * Q_BLOCK
        t = start + jnp.arange(Q_BLOCK, dtype=jnp.int32)
        qblk = lax.dynamic_slice_in_dim(q, start, Q_BLOCK, axis=1)
        outs, lses = [], []
        for window, dil in B_BRANCHES:
            half = window // (2 * dil)
            offs = dil * jnp.arange(-half, half + 1, dtype=jnp.int32)
            idx = t[:, None] + offs[None, :]
            valid = (idx >= 0) & (idx < s)
            idx_c = jnp.clip(idx, 0, s - 1)
            kg = k[:, idx_c]
            vg = v[:, idx_c]
            sc = jnp.einsum('bqhd,bqkhd->bhqk', qblk, kg).astype(jnp.float32) * scale
            sc = jnp.where(valid[None, None], sc, neg)
            lse = jax.nn.logsumexp(sc, axis=-1)
            p = jnp.exp(sc - lse[..., None]).astype(v.dtype)
            outs.append(jnp.einsum('bhqk,bqkhd->bqhd', p, vg))
            lses.append(lse)
        w = jax.nn.softmax(jnp.stack(lses, axis=0), axis=0)
        w = w.transpose(0, 1, 3, 2)[..., None].astype(v.dtype)
        return jnp.sum(w * jnp.stack(outs, axis=0), axis=0)

    o = lax.map(block, jnp.arange(nb, dtype=jnp.int32))
    return o.transpose(1, 0, 2, 3, 4).reshape(bn, s, h * d)


def diff_attention(q1, q2, k1, k2, v, lam):
    bn, s, h, d = q1.shape
    nb = s // Q_BLOCK
    scale = d ** -0.5
    q1b = q1.reshape(bn, nb, Q_BLOCK, h, d).transpose(1, 0, 2, 3, 4)
    q2b = q2.reshape(bn, nb, Q_BLOCK, h, d).transpose(1, 0, 2, 3, 4)

    def block(qs):
        qa, qb = qs
        s1 = jnp.einsum('bqhd,bshd->bhqs', qa, k1).astype(jnp.float32) * scale
        s2 = jnp.einsum('bqhd,bshd->bhqs', qb, k2).astype(jnp.float32) * scale
        p = jax.nn.softmax(s1, axis=-1) - lam * jax.nn.softmax(s2, axis=-1)
        return jnp.einsum('bhqs,bshe->bqhe', p.astype(v.dtype), v)

    o = lax.map(block, (q1b, q2b))
    return o.transpose(1, 0, 2, 3, 4).reshape(bn, s, h, v.shape[-1])


def swiglu(h, w_gate, w_up, w_down):
    return (jax.nn.silu(h @ w_gate) * (h @ w_up)) @ w_down


def setup_inputs(seed: int = 0) -> dict:
    key = jax.random.key(seed)
    ks = jax.random.split(key, 20)

    def dense(k, shape):
        return jax.random.normal(k, shape, jnp.float32) * shape[-2] ** -0.5

    def gain(k, shape):
        return 1.0 + 0.02 * jax.random.normal(k, shape, jnp.float32)

    return {
        "x": jax.random.normal(ks[0], (BATCH, SEQ, D_MODEL), jnp.float32),
        "attn_norm": gain(ks[1], (DEPTH, D_MODEL)),
        "ffn_norm": gain(ks[2], (DEPTH, D_MODEL)),
        "final_norm": gain(ks[3], (D_MODEL,)),
        "w_in_even": dense(ks[4], (N_EVEN, D_MODEL, EVEN_IN_W)),
        "a_q_norm": gain(ks[5], (N_EVEN, HEAD_DIM)),
        "a_k_norm": gain(ks[6], (N_EVEN, HEAD_DIM)),
        "w_out_even": dense(ks[7], (N_EVEN, EVEN_OUT_W, D_MODEL)),
        "w_in_odd": dense(ks[8], (N_ODD, D_MODEL, ODD_IN_W)),
        "lambda_q1": 0.1 * jax.random.normal(ks[9], (N_ODD, HEAD_DIM), jnp.float32),
        "lambda_k1": 0.1 * jax.random.normal(ks[10], (N_ODD, HEAD_DIM), jnp.float32),
        "lambda_q2": 0.1 * jax.random.normal(ks[11], (N_ODD, HEAD_DIM), jnp.float32),
        "lambda_k2": 0.1 * jax.random.normal(ks[12], (N_ODD, HEAD_DIM), jnp.float32),
        "c_sub_norm": gain(ks[13], (N_ODD, C_V_DIM)),
        "w_out_odd": dense(ks[14], (N_ODD, ODD_OUT_W, D_MODEL)),
        "w_gate": dense(ks[15], (DEPTH, D_MODEL, D_FF)),
        "w_up": dense(ks[16], (DEPTH, D_MODEL, D_FF)),
        "w_down": dense(ks[17], (DEPTH, D_FF, D_MODEL)),
    }


def reference(x, attn_norm, ffn_norm, final_norm, w_in_even, a_q_norm, a_k_norm, w_out_even,
              w_in_odd, lambda_q1, lambda_k1, lambda_q2, lambda_k2, c_sub_norm, w_out_odd,
              w_gate, w_up, w_down):
    bn, s, _ = x.shape
    rows = s // GRID_W
    row_ids = jnp.repeat(jnp.arange(rows, dtype=jnp.int32), GRID_W)
    col_ids = jnp.tile(jnp.arange(GRID_W, dtype=jnp.int32), rows)
    pos = jnp.arange(rows * GRID_W, dtype=jnp.int32)
    ang_1d = rope_angles(pos, HEAD_DIM)
    ang_2d = jnp.concatenate([rope_angles(row_ids, HEAD_DIM // 2),
                              rope_angles(col_ids, HEAD_DIM // 2)], axis=-1)

    for i in range(DEPTH):
        j = i // 2
        h = rms_norm(x, attn_norm[i])
        if i % 2 == 0:
            proj = h @ w_in_even[j]
            aq, ak, av, bq, bk, bv = jnp.split(proj, EVEN_SPLITS, axis=-1)
            aq = aq.reshape(bn, s, A_Q_HEADS, HEAD_DIM)
            ak = ak.reshape(bn, s, A_KV_HEADS, HEAD_DIM)
            av = av.reshape(bn, s, A_KV_HEADS, HEAD_DIM)
            aq = apply_rope(rms_norm(aq, a_q_norm[j]), ang_2d)
            ak = apply_rope(rms_norm(ak, a_k_norm[j]), ang_2d)
            bq = apply_rope(bq.reshape(bn, s, B_HEADS, HEAD_DIM), ang_1d)
            bk = apply_rope(bk.reshape(bn, s, B_HEADS, HEAD_DIM), ang_1d)
            bv = bv.reshape(bn, s, B_HEADS, HEAD_DIM)
            mix = jnp.concatenate([gqa_attention(aq, ak, av),
                                   dilated_attention(bq, bk, bv)], axis=-1)
            x = x + mix @ w_out_even[j]
        else:
            proj = h @ w_in_odd[j]
            q, k, v = jnp.split(proj, ODD_SPLITS, axis=-1)
            q = q.reshape(bn, s, C_HEADS, 2, HEAD_DIM)
            k = k.reshape(bn, s, C_HEADS, 2, HEAD_DIM)
            v = v.reshape(bn, s, C_HEADS, C_V_DIM)
            q1 = apply_rope(q[..., 0, :], ang_1d)
            q2 = apply_rope(q[..., 1, :], ang_1d)
            k1 = apply_rope(k[..., 0, :], ang_1d)
            k2 = apply_rope(k[..., 1, :], ang_1d)
            lam_init = 0.8 - 0.6 * math.exp(-0.3 * i)
            lam = (jnp.exp(jnp.sum(lambda_q1[j].astype(jnp.float32) * lambda_k1[j].astype(jnp.float32)))
                   - jnp.exp(jnp.sum(lambda_q2[j].astype(jnp.float32) * lambda_k2[j].astype(jnp.float32)))
                   + lam_init)
            o = diff_attention(q1, q2, k1, k2, v, lam)
            o = rms_norm(o, c_sub_norm[j]) * (1.0 - lam_init)
            x = x + o.reshape(bn, s, ODD_OUT_W) @ w_out_odd[j]
        h = rms_norm(x, ffn_norm[i])
        x = x + swiglu(h, w_gate[i], w_up[i], w_down[i])
    return rms_norm(x, final_norm)
```

```cpp
#include <hip/hip_runtime.h>
#include <cstdint>
#include <cstdio>
#include <cmath>

namespace nv {
constexpr int S = 8192, NB = 2, M = NB * S, D = 1024, FF = 2816;
constexpr float EPS = 1e-6f;
constexpr float LAM_INIT = 0.35550906f;

__global__ void __launch_bounds__(256) rmsnorm_k(const float* x, const float* g, float* out) {
    const int row = blockIdx.x * 4 + (threadIdx.x >> 6), lane = threadIdx.x & 63;
    const float4* xr = (const float4*)(x + (size_t)row * D);
    float4 v[4]; float s = 0.f;
#pragma unroll
    for (int j = 0; j < 4; ++j) { v[j] = xr[lane + 64 * j]; s += v[j].x * v[j].x + v[j].y * v[j].y + v[j].z * v[j].z + v[j].w * v[j].w; }
#pragma unroll
    for (int o = 1; o < 64; o <<= 1) s += __shfl_xor(s, o);
    const float r = 1.0f / sqrtf(s * (1.f / D) + EPS);
    const float4* gr = (const float4*)g; float4* orow = (float4*)(out + (size_t)row * D);
#pragma unroll
    for (int j = 0; j < 4; ++j) { const float4 gg = gr[lane + 64 * j]; float4 o; o.x = v[j].x * r * gg.x; o.y = v[j].y * r * gg.y; o.z = v[j].z * r * gg.z; o.w = v[j].w * r * gg.w; orow[lane + 64 * j] = o; }
}

template <int DUAL> __global__ void __launch_bounds__(256) gemm_k(const float* A, const float* Bm, const float* B2, float* C, const float* R, int N, int K) {
    __shared__ float As[16][68]; __shared__ float Bs[16][64]; __shared__ float Bs2[DUAL ? 16 : 1][64];
    const int tid = threadIdx.x, tx = tid & 15, ty = tid >> 4;
    const int row0 = blockIdx.y * 64, col0 = blockIdx.x * 64;
    float acc[4][4], acc2[4][4];
#pragma unroll
    for (int i = 0; i < 4; ++i)
#pragma unroll
        for (int j = 0; j < 4; ++j) { acc[i][j] = 0.f; acc2[i][j] = 0.f; }
    for (int k0 = 0; k0 < K; k0 += 16) {
        { const int r = tid >> 2, kk = (tid & 3) * 4; const float4 a = *(const float4*)(A + (size_t)(row0 + r) * K + k0 + kk); As[kk][r] = a.x; As[kk + 1][r] = a.y; As[kk + 2][r] = a.z; As[kk + 3][r] = a.w; }
        { const int kk = tid >> 4, c = (tid & 15) * 4; *(float4*)&Bs[kk][c] = *(const float4*)(Bm + (size_t)(k0 + kk) * N + col0 + c);
          if (DUAL) *(float4*)&Bs2[kk][c] = *(const float4*)(B2 + (size_t)(k0 + kk) * N + col0 + c); }
        __syncthreads();
#pragma unroll
        for (int kk = 0; kk < 16; ++kk) {
            const float4 a = *(const float4*)&As[kk][ty * 4]; const float4 b = *(const float4*)&Bs[kk][tx * 4];
            const float av[4] = {a.x, a.y, a.z, a.w}, bv[4] = {b.x, b.y, b.z, b.w};
#pragma unroll
            for (int i = 0; i < 4; ++i)
#pragma unroll
                for (int j = 0; j < 4; ++j) acc[i][j] += av[i] * bv[j];
            if (DUAL) { const float4 b2 = *(const float4*)&Bs2[kk][tx * 4]; const float b2v[4] = {b2.x, b2.y, b2.z, b2.w};
#pragma unroll
                for (int i = 0; i < 4; ++i)
#pragma unroll
                    for (int j = 0; j < 4; ++j) acc2[i][j] += av[i] * b2v[j]; }
        }
        __syncthreads();
    }
#pragma unroll
    for (int i = 0; i < 4; ++i) {
        const size_t off = (size_t)(row0 + ty * 4 + i) * N + col0 + tx * 4; float4 o;
        float ov[4];
#pragma unroll
        for (int j = 0; j < 4; ++j) { float v = acc[i][j]; if (DUAL) { const float g = v; v = g / (1.f + expf(-g)) * acc2[i][j]; } ov[j] = v; }
        o.x = ov[0]; o.y = ov[1]; o.z = ov[2]; o.w = ov[3];
        if (R) { const float4 r = *(const float4*)(R + off); o.x += r.x; o.y += r.y; o.z += r.z; o.w += r.w; }
        *(float4*)(C + off) = o;
    }
}

__global__ void __launch_bounds__(64) rope_k(float* P, int pitch, int layer, const float* qn, const float* kn) {
    const int tok = blockIdx.x, slot = blockIdx.y, d = threadIdx.x, i = d & 31;
    const int t = tok % S;
    int col, mode;
    if (layer == 0) { if (slot < 8) { col = slot * 64; mode = 1; } else if (slot < 10) { col = 512 + (slot - 8) * 64; mode = 2; } else { col = 768 + (slot - 10) * 64; mode = 0; } }
    else { col = slot * 64; mode = 0; }
    float* p = P + (size_t)tok * pitch + col;
    float y = p[d];
    if (mode) { float s = y * y;
#pragma unroll
        for (int o = 1; o < 64; o <<= 1) s += __shfl_xor(s, o);
        y = y * (1.0f / sqrtf(s * (1.f / 64.f) + EPS)) * (mode == 1 ? qn[d] : kn[d]); }
    float ang;
    if (mode == 0) ang = (float)t * powf(10000.f, -(float)(2 * i) / 64.f);
    else { const int ii = i & 15; const float inv = powf(10000.f, -(float)(2 * ii) / 32.f); ang = (float)(i < 16 ? t / 64 : t % 64) * inv; }
    float sn, cs; sincosf(ang, &sn, &cs);
    const float other = __shfl_xor(y, 32);
    const float o = d < 32 ? y * cs - other * sn : other * sn + y * cs;
    p[d] = o;
}

struct AttnP { const float* Q; const float* K; const float* V; float* O; int pitch, opitch; int qoff, qgrp, qhs, koff, kgrp, khs, voff, vgrp, vhs, ooff, ohs; int mode, accum; const float *lq1, *lk1, *lq2, *lk2; };
__global__ void __launch_bounds__(128) attn_k(AttnP p) {
    __shared__ float Ks[32][64]; __shared__ float Vs[32][64];
    const int q0 = blockIdx.x * 128, t = q0 + threadIdx.x, head = blockIdx.y, b = blockIdx.z;
    const size_t rowb = (size_t)b * S;
    const float* qp = p.Q + (rowb + t) * p.pitch + p.qoff + (head / p.qgrp) * p.qhs;
    const int kcol = p.koff + (head / p.kgrp) * p.khs, vcol = p.voff + (head / p.vgrp) * p.vhs;
    float q[64], o[64];
#pragma unroll
    for (int d = 0; d < 64; d += 4) { const float4 v = *(const float4*)(qp + d); q[d] = v.x * 0.125f; q[d + 1] = v.y * 0.125f; q[d + 2] = v.z * 0.125f; q[d + 3] = v.w * 0.125f; }
#pragma unroll
    for (int d = 0; d < 64; ++d) o[d] = 0.f;
    float m = -1e30f, l = 0.f;
    int klo = 0, khi = S; if (p.mode == 1) { klo = q0 - 1024 < 0 ? 0 : q0 - 1024; khi = q0 + 128 + 1024 > S ? S : q0 + 128 + 1024; }
    for (int k0 = klo; k0 < khi; k0 += 32) {
        __syncthreads();
        for (int i = threadIdx.x; i < 512; i += 128) { const int r = i >> 4, c = (i & 15) * 4;
            *(float4*)&Ks[r][c] = *(const float4*)(p.K + (rowb + k0 + r) * p.pitch + kcol + c);
            *(float4*)&Vs[r][c] = *(const float4*)(p.V + (rowb + k0 + r) * p.pitch + vcol + c); }
        __syncthreads();
#pragma unroll 1
        for (int jc = 0; jc < 32; jc += 8) {
            float s[8];
#pragma unroll
            for (int j = 0; j < 8; ++j) { float a = 0.f;
#pragma unroll
                for (int d = 0; d < 64; d += 4) { const float4 kv = *(const float4*)&Ks[jc + j][d]; a += q[d] * kv.x + q[d + 1] * kv.y + q[d + 2] * kv.z + q[d + 3] * kv.w; }
                if (p.mode == 1) { const int off = (k0 + jc + j) - t, ao = off < 0 ? -off : off;
                    const int mm = (ao <= 64 ? 1 : 0) + ((((off & 3) == 0) && ao <= 256) ? 1 : 0) + ((((off & 15) == 0) && ao <= 1024) ? 1 : 0);
                    a = mm == 0 ? -1e30f : a + logf((float)mm); }
                s[j] = a; }
            float mx = s[0];
#pragma unroll
            for (int j = 1; j < 8; ++j) mx = fmaxf(mx, s[j]);
            if (mx > m) { const float sc = expf(m - mx); l *= sc;
#pragma unroll
                for (int d = 0; d < 64; ++d) o[d] *= sc;
                m = mx; }
#pragma unroll
            for (int j = 0; j < 8; ++j) { const float pj = expf(s[j] - m); l += pj;
#pragma unroll
                for (int d = 0; d < 64; d += 4) { const float4 vv = *(const float4*)&Vs[jc + j][d]; o[d] += pj * vv.x; o[d + 1] += pj * vv.y; o[d + 2] += pj * vv.z; o[d + 3] += pj * vv.w; } }
        }
    }
    float coef = 1.0f / l;
    if (p.accum) { float s1 = 0.f, s2 = 0.f; for (int d = 0; d < 64; ++d) { s1 += p.lq1[d] * p.lk1[d]; s2 += p.lq2[d] * p.lk2[d]; } const float lam = expf(s1) - expf(s2) + LAM_INIT; coef *= -lam; }
    float* op = p.O + (rowb + t) * p.opitch + p.ooff + head * p.ohs;
#pragma unroll
    for (int d = 0; d < 64; d += 4) { float4 v; v.x = o[d] * coef; v.y = o[d + 1] * coef; v.z = o[d + 2] * coef; v.w = o[d + 3] * coef;
        if (p.accum) { const float4 old = *(const float4*)(op + d); v.x += old.x; v.y += old.y; v.z += old.z; v.w += old.w; }
        *(float4*)(op + d) = v; }
}

__global__ void __launch_bounds__(64) subnorm_k(float* O, const float* g) {
    float* p = O + (size_t)blockIdx.x * 1024 + blockIdx.y * 128; const int d = threadIdx.x;
    const float a = p[d], b = p[d + 64]; float s = a * a + b * b;
#pragma unroll
    for (int o = 1; o < 64; o <<= 1) s += __shfl_xor(s, o);
    const float r = (1.0f / sqrtf(s * (1.f / 128.f) + EPS)) * (1.0f - LAM_INIT);
    p[d] = a * r * g[d]; p[d + 64] = b * r * g[d + 64];
}

static void ffn(const float* xin_out_stream, float* xs, const float* fnorm, const float* wg, const float* wu, const float* wd, float* regA, float* regB, hipStream_t st) {
    hipLaunchKernelGGL(rmsnorm_k, dim3(M / 4), dim3(256), 0, st, xs, fnorm, regB);
    hipLaunchKernelGGL(gemm_k<1>, dim3(FF / 64, M / 64), dim3(256), 0, st, regB, wg, wu, regA, (const float*)nullptr, FF, D);
    hipLaunchKernelGGL(gemm_k<0>, dim3(D / 64, M / 64), dim3(256), 0, st, regA, wd, (const float*)nullptr, xs, xs, D, FF);
}
}

extern "C" void kernel_launch(void* const* d_in, const int* in_sizes, int n_in, void* d_out, int out_size, void* d_ws, size_t ws_size, hipStream_t stream) {
    using namespace nv;
    const float* x = (const float*)d_in[0]; const float* attn_norm = (const float*)d_in[1]; const float* ffn_norm = (const float*)d_in[2]; const float* final_norm = (const float*)d_in[3];
    const float* w_in_even = (const float*)d_in[4]; const float* a_q_norm = (const float*)d_in[5]; const float* a_k_norm = (const float*)d_in[6]; const float* w_out_even = (const float*)d_in[7];
    const float* w_in_odd = (const float*)d_in[8]; const float* lq1 = (const float*)d_in[9]; const float* lk1 = (const float*)d_in[10]; const float* lq2 = (const float*)d_in[11]; const float* lk2 = (const float*)d_in[12];
    const float* c_sub = (const float*)d_in[13]; const float* w_out_odd = (const float*)d_in[14]; const float* w_gate = (const float*)d_in[15]; const float* w_up = (const float*)d_in[16]; const float* w_down = (const float*)d_in[17];
    float* xs = (float*)d_out;
    float* regA = (float*)d_ws;
    float* regB = (float*)((char*)d_ws + (size_t)192 * 1024 * 1024);
    hipLaunchKernelGGL(rmsnorm_k, dim3(M / 4), dim3(256), 0, stream, x, attn_norm, regB);
    hipLaunchKernelGGL(gemm_k<0>, dim3(2304 / 64, M / 64), dim3(256), 0, stream, regB, w_in_even, (const float*)nullptr, regA, (const float*)nullptr, 2304, D);
    hipLaunchKernelGGL(rope_k, dim3(M, 26), dim3(64), 0, stream, regA, 2304, 0, a_q_norm, a_k_norm);
    { AttnP p{}; p.Q = regA; p.K = regA; p.V = regA; p.O = regB; p.pitch = 2304; p.opitch = 1024;
      p.qoff = 0; p.qgrp = 1; p.qhs = 64; p.koff = 512; p.kgrp = 4; p.khs = 64; p.voff = 640; p.vgrp = 4; p.vhs = 64; p.ooff = 0; p.ohs = 64; p.mode = 0; p.accum = 0;
      hipLaunchKernelGGL(attn_k, dim3(S / 128, 8, NB), dim3(128), 0, stream, p);
      p.qoff = 768; p.koff = 1280; p.kgrp = 1; p.voff = 1792; p.vgrp = 1; p.ooff = 512; p.mode = 1;
      hipLaunchKernelGGL(attn_k, dim3(S / 128, 8, NB), dim3(128), 0, stream, p); }
    hipLaunchKernelGGL(gemm_k<0>, dim3(D / 64, M / 64), dim3(256), 0, stream, regB, w_out_even, (const float*)nullptr, xs, x, D, D);
    ffn(nullptr, xs, ffn_norm, w_gate, w_up, w_down, regA, regB, stream);
    hipLaunchKernelGGL(rmsnorm_k, dim3(M / 4), dim3(256), 0, stream, xs, attn_norm + D, regB);
    hipLaunchKernelGGL(gemm_k<0>, dim3(3072 / 64, M / 64), dim3(256), 0, stream, regB, w_in_odd, (const float*)nullptr, regA, (const float*)nullptr, 3072, D);
    hipLaunchKernelGGL(rope_k, dim3(M, 32), dim3(64), 0, stream, regA, 3072, 1, a_q_norm, a_k_norm);
    { AttnP p{}; p.Q = regA; p.K = regA; p.V = regA; p.O = regB; p.pitch = 3072; p.opitch = 1024;
      p.qoff = 0; p.qgrp = 2; p.qhs = 128; p.koff = 1024; p.kgrp = 2; p.khs = 128; p.voff = 2048; p.vgrp = 1; p.vhs = 64; p.ooff = 0; p.ohs = 64; p.mode = 0; p.accum = 0;
      p.lq1 = lq1; p.lk1 = lk1; p.lq2 = lq2; p.lk2 = lk2;
      hipLaunchKernelGGL(attn_k, dim3(S / 128, 16, NB), dim3(128), 0, stream, p);
      p.qoff = 64; p.koff = 1024 + 64; p.accum = 1;
      hipLaunchKernelGGL(attn_k, dim3(S / 128, 16, NB), dim3(128), 0, stream, p); }
    hipLaunchKernelGGL(subnorm_k, dim3(M, 8), dim3(64), 0, stream, regB, c_sub);
    hipLaunchKernelGGL(gemm_k<0>, dim3(D / 64, M / 64), dim3(256), 0, stream, regB, w_out_odd, (const float*)nullptr, xs, xs, D, D);
    ffn(nullptr, xs, ffn_norm + D, w_gate + (size_t)D * FF, w_up + (size_t)D * FF, w_down + (size_t)FF * D, regA, regB, stream);
    hipLaunchKernelGGL(rmsnorm_k, dim3(M / 4), dim3(256), 0, stream, xs, final_norm, xs);
}
```

```cpp
#include <hip/hip_runtime.h>
#include <cstdio>
#include <cstdint>
namespace pg8 {
#define PG8_LAS __attribute__((address_space(3)))
typedef unsigned short bf16_t;
typedef short bf16x8 __attribute__((ext_vector_type(8)));
typedef float f32x4 __attribute__((ext_vector_type(4)));
typedef unsigned u32x4 __attribute__((ext_vector_type(4)));
constexpr int BM = 256, BK = 64, HALF = 128, HTB = HALF * BK * 2  , STAGE_BYTES = 8 * HTB, NXCD = 8, WGM = 8;

__host__ __device__ __forceinline__ int lds_byte(int r, int c) { const int st = (r >> 4) * 2 + (c >> 5), rr = r & 15, cc = c & 31, ob = rr * 64 + cc * 2; return st * 1024 + (ob ^ (((ob >> 9) & 1) << 5)); }
__host__ __device__ __forceinline__ void stage_rc(int b, int& R, int& C) { const int st = b / 1024, sb = b % 1024, swz = sb ^ (((sb >> 9) & 1) << 5); R = (st >> 1) * 16 + swz / 64; C = (st & 1) * 32 + (swz % 64) / 2; }
__host__ __device__ __forceinline__ int perm32(int rho) { const int n = rho >> 4, i = rho & 15; return 8 * (i >> 2) + 4 * n + (i & 3); }

struct Unit { int pm, pn; };
struct Gemm { const bf16_t* A; const bf16_t* Bt; int M, N, K; };

struct StaticOrder {
    int nM, nN, nwg, G, c;
    __host__ __device__ void init(int M, int N, int G_, int c_) { nM = M / BM; nN = N / BM; nwg = nM * nN; G = G_; c = c_; }
    __host__ __device__ bool next(int i, Unit& u) const {
        const long L = (long)i * G + c; if (L >= nwg) return false;
        int wgid = (int)L; { const int q = nwg / NXCD, r = nwg % NXCD, xcd = wgid % NXCD, off = wgid / NXCD; wgid = (xcd < r ? xcd * (q + 1) : r * (q + 1) + (xcd - r) * q) + off; }
        const int nig = WGM * nN, gid = wgid / nig, fm = gid * WGM, gsz = (nM - fm) < WGM ? (nM - fm) : WGM;
        u.pm = fm + ((wgid % nig) % gsz); u.pn = (wgid % nig) / gsz; return true;
    }
    __device__ __forceinline__ void a_ready(const Unit&) const {}
    __device__ __forceinline__ void done(const Unit&) const {}
};

__device__ __forceinline__ unsigned cvt_pk_bf16(float lo, float hi) { unsigned r; asm volatile("v_cvt_pk_bf16_f32 %0, %1, %2" : "=v"(r) : "v"(lo), "v"(hi)); return r; }
typedef float f32x2 __attribute__((ext_vector_type(2)));
constexpr float RMS_EPS = 1e-6f;
struct EpiProj {
    static constexpr bool PERM = true, AFTER_DRAIN = false;
    bf16_t* O; int ldc; const float* ss;
    __device__ __forceinline__ void operator()(const f32x4 (&acc)[2][2][4][2], const Unit& u, int wr, int wc, int fr, int fq) const {
        const int row0 = u.pm * BM + wr * 64 + fr, col0 = u.pn * BM + wc * 32 + 8 * fq;
#pragma unroll
        for (int ai = 0; ai < 2; ++ai)
#pragma unroll
            for (int m = 0; m < 4; ++m) { const int row = row0 + ai * HALF + m * 16; const float r = rsqrtf(ss[row] * (1.0f / 1024.0f) + RMS_EPS);
                bf16_t* rowp = O + (size_t)row * ldc + col0;
#pragma unroll
                for (int bj = 0; bj < 2; ++bj) { const f32x4 v0 = acc[ai][bj][m][0] * r, v1 = acc[ai][bj][m][1] * r; u32x4 w;
                    w.x = cvt_pk_bf16(v0[0], v0[1]); w.y = cvt_pk_bf16(v0[2], v0[3]); w.z = cvt_pk_bf16(v1[0], v1[1]); w.w = cvt_pk_bf16(v1[2], v1[3]);
                    *(u32x4*)(rowp + bj * HALF) = w; } }
    }
};
__device__ __forceinline__ float silu_mul(float g, float u) { return g * __builtin_amdgcn_rcpf(1.0f + __expf(-g)) * u; }
struct EpiSwiGLU {
    static constexpr bool PERM = true, AFTER_DRAIN = false;
    bf16_t* H; int ldc; const float* ss;
    __device__ __forceinline__ void operator()(const f32x4 (&acc)[2][2][4][2], const Unit& u, int wr, int wc, int fr, int fq) const {
        const int row0 = u.pm * BM + wr * 64 + fr, col0 = u.pn * HALF + wc * 32 + 8 * fq;
#pragma unroll
        for (int ai = 0; ai < 2; ++ai)
#pragma unroll
            for (int m = 0; m < 4; ++m) { const int row = row0 + ai * HALF + m * 16; const float r = rsqrtf(ss[row] * (1.0f / 1024.0f) + RMS_EPS);
                const f32x4 g0 = acc[ai][0][m][0] * r, g1 = acc[ai][0][m][1] * r, u0 = acc[ai][1][m][0] * r, u1 = acc[ai][1][m][1] * r; u32x4 w;
                w.x = cvt_pk_bf16(silu_mul(g0[0], u0[0]), silu_mul(g0[1], u0[1])); w.y = cvt_pk_bf16(silu_mul(g0[2], u0[2]), silu_mul(g0[3], u0[3]));
                w.z = cvt_pk_bf16(silu_mul(g1[0], u1[0]), silu_mul(g1[1], u1[1])); w.w = cvt_pk_bf16(silu_mul(g1[2], u1[2]), silu_mul(g1[3], u1[3]));
                *(u32x4*)(H + (size_t)row * ldc + col0) = w; }
    }
};
struct EpiResid {
    static constexpr bool PERM = true, AFTER_DRAIN = false;
    const float* base; float* out; bf16_t* xb; float* ssn;
    __device__ __forceinline__ void operator()(const f32x4 (&acc)[2][2][4][2], const Unit& u, int wr, int wc, int fr, int fq) const {
        const int row0 = u.pm * BM + wr * 64 + fr, col0 = u.pn * BM + wc * 32 + 8 * fq;
#pragma unroll
        for (int ai = 0; ai < 2; ++ai)
#pragma unroll
            for (int m = 0; m < 4; ++m) { const int row = row0 + ai * HALF + m * 16; const size_t off = (size_t)row * 1024 + col0; float q = 0.f;
#pragma unroll
                for (int bj = 0; bj < 2; ++bj) { const f32x4 b0 = *(const f32x4*)(base + off + bj * HALF), b1 = *(const f32x4*)(base + off + bj * HALF + 4);
                    const f32x4 x0 = b0 + acc[ai][bj][m][0], x1 = b1 + acc[ai][bj][m][1];
                    *(f32x4*)(out + off + bj * HALF) = x0; *(f32x4*)(out + off + bj * HALF + 4) = x1;
                    q += (x0[0] * x0[0] + x0[1] * x0[1]) + (x0[2] * x0[2] + x0[3] * x0[3]) + (x1[0] * x1[0] + x1[1] * x1[1]) + (x1[2] * x1[2] + x1[3] * x1[3]);
                    u32x4 w; w.x = cvt_pk_bf16(x0[0], x0[1]); w.y = cvt_pk_bf16(x0[2], x0[3]); w.z = cvt_pk_bf16(x1[0], x1[1]); w.w = cvt_pk_bf16(x1[2], x1[3]);
                    *(u32x4*)(xb + off + bj * HALF) = w; }
                q += __shfl_xor(q, 16); q += __shfl_xor(q, 32);
                if (fq == 0) __hip_atomic_fetch_add(ssn + row, q, __ATOMIC_RELAXED, __HIP_MEMORY_SCOPE_AGENT);
                asm volatile("" ::: "memory"); }
    }
};

template <class Epi, class Sched, bool ALIGN_EPI = false, bool SP2 = false>
__device__ __forceinline__ void gemm_phase(PG8_LAS unsigned char* lds, const Gemm g, const Sched& S, const Epi& E) {
    const int tid = threadIdx.x, wid = __builtin_amdgcn_readfirstlane(tid >> 6), lane = tid & 63, wr = wid >> 2, wc = wid & 3, fr = lane & 15, fq = lane >> 4;
    const int K = g.K, nt = K / BK;
    unsigned voffA[2], voffB[2];
#pragma unroll
    for (int i = 0; i < 2; ++i) { int R, C; stage_rc(tid * 16 + i * 8192, R, C); const int Rb = Epi::PERM ? ((R & ~31) + perm32(R & 31)) : R;
        voffA[i] = (unsigned)(R * K + C) * 2u; voffB[i] = (unsigned)(Rb * K + C) * 2u; }
    const size_t kstep = (size_t)(BK * 2);
    const size_t hstep = (size_t)HALF * K * 2;
    const size_t tstep = 2 * hstep;
    const unsigned ldsw = (unsigned)wid * 1024u;
    const int aoff = lds_byte(wr * 64 + fr, fq * 8), boff = lds_byte(wc * 32 + fr, fq * 8);
#define PG8_SA(b, h) (((b) * 2 + (h)) * HTB)
#define PG8_SB(b, h) ((4 + (b) * 2 + (h)) * HTB)
#define PG8_STAGE(bufoff, gbase, voff) do { _Pragma("unroll") for (int _i = 0; _i < 2; ++_i) \
        __builtin_amdgcn_global_load_lds((const unsigned*)((const char*)(gbase) + (voff)[_i]), (PG8_LAS unsigned*)(lds + (bufoff) + ldsw + _i * 8192), 16, 0, 0); } while (0)
#define PG8_LDA(dst, b, h) do { _Pragma("unroll") for (int m = 0; m < 4; ++m) _Pragma("unroll") for (int k = 0; k < 2; ++k) dst[m][k] = *(const PG8_LAS bf16x8*)(lds + PG8_SA(b, h) + aoff + m * 2048 + k * 1024); } while (0)
#define PG8_LDB(dst, b, h) do { _Pragma("unroll") for (int n = 0; n < 2; ++n) _Pragma("unroll") for (int k = 0; k < 2; ++k) dst[n][k] = *(const PG8_LAS bf16x8*)(lds + PG8_SB(b, h) + boff + n * 2048 + k * 1024); } while (0)
#define PG8_MMA(ai, bj, At, Bt) do { __builtin_amdgcn_s_setprio(1); _Pragma("unroll") for (int m = 0; m < 4; ++m) _Pragma("unroll") for (int n = 0; n < 2; ++n) _Pragma("unroll") for (int k = 0; k < 2; ++k) \
        acc[ai][bj][m][n] = __builtin_amdgcn_mfma_f32_16x16x32_bf16(Bt[n][k], At[m][k], acc[ai][bj][m][n], 0, 0, 0); __builtin_amdgcn_s_setprio(0); } while (0)
#define PG8_WAIT_V(n) asm volatile("s_waitcnt vmcnt(" #n ")" ::: "memory")
#define PG8_WAIT_L(n) asm volatile("s_waitcnt lgkmcnt(" #n ")" ::: "memory")
#define PG8_BAR __builtin_amdgcn_s_barrier()
#define PG8_SCHED __builtin_amdgcn_sched_barrier(0)
    Unit cur, nxt; int ui = 0;
    if (!S.next(0, cur)) return;
    f32x4 acc[2][2][4][2];
#pragma unroll
    for (int a = 0; a < 2; ++a)
#pragma unroll
        for (int b = 0; b < 2; ++b)
#pragma unroll
            for (int m = 0; m < 4; ++m)
#pragma unroll
                for (int n = 0; n < 2; ++n) acc[a][b][m][n] = (f32x4){0.f, 0.f, 0.f, 0.f};
    bf16x8 At[4][2], B0[2][2], B1[2][2];
    const char* cA = (const char*)g.A + (size_t)cur.pm * tstep; const char* cB = (const char*)g.Bt + (size_t)cur.pn * tstep;
    S.a_ready(cur);
    if constexpr (SP2) {
        PG8_STAGE(PG8_SB(0, 0), cB, voffB); PG8_STAGE(PG8_SB(0, 1), cB + hstep, voffB); PG8_STAGE(PG8_SA(0, 0), cA, voffA); PG8_STAGE(PG8_SA(0, 1), cA + hstep, voffA);
        if (wr == 1) PG8_BAR;
        PG8_WAIT_V(2); PG8_BAR;
        PG8_STAGE(PG8_SB(1, 0), cB + kstep, voffB); PG8_STAGE(PG8_SA(1, 0), cA + kstep, voffA); PG8_STAGE(PG8_SB(1, 1), cB + hstep + kstep, voffB);
        PG8_WAIT_V(6); PG8_BAR;
    } else {
        PG8_STAGE(PG8_SB(0, 0), cB, voffB); PG8_STAGE(PG8_SA(0, 0), cA, voffA); PG8_STAGE(PG8_SB(0, 1), cB + hstep, voffB); PG8_STAGE(PG8_SA(0, 1), cA + hstep, voffA);
        if (wr == 1) PG8_BAR;
        PG8_WAIT_V(4); PG8_BAR;
        PG8_STAGE(PG8_SB(1, 0), cB + kstep, voffB); PG8_STAGE(PG8_SA(1, 0), cA + kstep, voffA); PG8_STAGE(PG8_SB(1, 1), cB + hstep + kstep, voffB);
        PG8_WAIT_V(6); PG8_BAR;
    }
    for (;;) {
        const bool has_next = S.next(ui + 1, nxt);
        const char* nA = has_next ? (const char*)g.A + (size_t)nxt.pm * tstep : cA; const char* nB = has_next ? (const char*)g.Bt + (size_t)nxt.pn * tstep : cB;
        for (int t = 0; t < nt; t += 2) {
            const bool last = (t == nt - 2);
            const char* a1 = cA + (size_t)(t + 1) * kstep;
            const char* a2 = last ? nA : cA + (size_t)(t + 2) * kstep; const char* b2 = last ? nB : cB + (size_t)(t + 2) * kstep;
            const char* a3 = a2 + kstep; const char* b3 = b2 + kstep;
            if (last && has_next) S.a_ready(nxt);
            if constexpr (SP2) {
            PG8_LDB(B0, 0, 0); PG8_LDB(B1, 0, 1); PG8_SCHED; PG8_LDA(At, 0, 0); PG8_STAGE(PG8_SA(1, 1), a1 + hstep, voffA);
            PG8_WAIT_V(8); PG8_WAIT_L(0); PG8_BAR; PG8_MMA(0, 0, At, B0); PG8_MMA(0, 1, At, B1); PG8_BAR; PG8_SCHED;
            PG8_LDA(At, 0, 1); PG8_STAGE(PG8_SB(0, 0), b2, voffB); PG8_STAGE(PG8_SB(0, 1), b2 + hstep, voffB); PG8_STAGE(PG8_SA(0, 0), a2, voffA);
            PG8_WAIT_V(8); PG8_WAIT_L(0); PG8_BAR; PG8_MMA(1, 0, At, B0); PG8_MMA(1, 1, At, B1); PG8_BAR; PG8_SCHED;
            PG8_LDB(B0, 1, 0); PG8_LDB(B1, 1, 1); PG8_SCHED; PG8_LDA(At, 1, 0); PG8_STAGE(PG8_SA(0, 1), a2 + hstep, voffA);
            PG8_WAIT_V(8); PG8_WAIT_L(0); PG8_BAR; PG8_MMA(0, 0, At, B0); PG8_MMA(0, 1, At, B1); PG8_BAR; PG8_SCHED;
            PG8_LDA(At, 1, 1); PG8_STAGE(PG8_SB(1, 0), b3, voffB); PG8_STAGE(PG8_SB(1, 1), b3 + hstep, voffB); PG8_STAGE(PG8_SA(1, 0), a3, voffA);
            PG8_WAIT_V(8); PG8_WAIT_L(0); PG8_BAR; PG8_MMA(1, 0, At, B0); PG8_MMA(1, 1, At, B1); PG8_BAR; PG8_SCHED;
            } else {
            PG8_LDB(B0, 0, 0); PG8_SCHED; PG8_LDA(At, 0, 0); PG8_STAGE(PG8_SA(1, 1), a1 + hstep, voffA);
            PG8_WAIT_L(8); PG8_BAR; PG8_WAIT_L(0); PG8_MMA(0, 0, At, B0); PG8_BAR; PG8_SCHED;
            PG8_LDB(B1, 0, 1); PG8_STAGE(PG8_SB(0, 0), b2, voffB);
            PG8_BAR; PG8_WAIT_L(0); PG8_MMA(0, 1, At, B1); PG8_BAR;
            PG8_LDA(At, 0, 1); PG8_STAGE(PG8_SA(0, 0), a2, voffA);
            PG8_BAR; PG8_WAIT_L(0); PG8_MMA(1, 0, At, B0); PG8_BAR; PG8_SCHED;
            PG8_STAGE(PG8_SB(0, 1), b2 + hstep, voffB);
            PG8_WAIT_V(6); PG8_BAR; PG8_MMA(1, 1, At, B1); PG8_BAR;
            PG8_LDB(B0, 1, 0); PG8_SCHED; PG8_LDA(At, 1, 0); PG8_STAGE(PG8_SA(0, 1), a2 + hstep, voffA);
            PG8_WAIT_L(8); PG8_BAR; PG8_WAIT_L(0); PG8_MMA(0, 0, At, B0); PG8_BAR; PG8_SCHED;
            PG8_LDB(B1, 1, 1); PG8_STAGE(PG8_SB(1, 0), b3, voffB);
            PG8_BAR; PG8_WAIT_L(0); PG8_MMA(0, 1, At, B1); PG8_BAR;
            PG8_LDA(At, 1, 1); PG8_STAGE(PG8_SA(1, 0), a3, voffA);
            PG8_BAR; PG8_WAIT_L(0); PG8_MMA(1, 0, At, B0); PG8_BAR; PG8_SCHED;
            PG8_STAGE(PG8_SB(1, 1), b3 + hstep, voffB);
            PG8_WAIT_V(6); PG8_BAR; PG8_MMA(1, 1, At, B1); PG8_BAR;
            }
        }
        if constexpr (ALIGN_EPI) { if (wr == 0) PG8_BAR; }
        if constexpr (!Epi::AFTER_DRAIN) { E(acc, cur, wr, wc, fr, fq); S.done(cur); }
        if (!has_next) break;
#pragma unroll
        for (int a = 0; a < 2; ++a)
#pragma unroll
            for (int b = 0; b < 2; ++b)
#pragma unroll
                for (int m = 0; m < 4; ++m)
#pragma unroll
                    for (int n = 0; n < 2; ++n) acc[a][b][m][n] = (f32x4){0.f, 0.f, 0.f, 0.f};
        cur = nxt; cA = nA; cB = nB; ++ui;
        if constexpr (ALIGN_EPI) { if (wr == 1) PG8_BAR; }
    }
    PG8_WAIT_V(0);
    if constexpr (!ALIGN_EPI) { if (wr == 0) PG8_BAR; }
    PG8_BAR;
    if constexpr (Epi::AFTER_DRAIN) { E.fused(acc, cur, wr, wc, fr, fq, lds, wid, lane); S.done(cur); }
#undef PG8_SA
#undef PG8_SB
#undef PG8_STAGE
#undef PG8_LDA
#undef PG8_LDB
#undef PG8_MMA
#undef PG8_WAIT_V
#undef PG8_WAIT_L
#undef PG8_BAR
#undef PG8_SCHED
}
}

#ifndef PG8_SP2
#define PG8_SP2 true
#endif
#ifndef PG8_ALIGN
#define PG8_ALIGN true
#endif
#include <hip/hip_bf16.h>
#include <cmath>
namespace attn_body {
using bf16=__hip_bfloat16;
using bf16x8=__attribute__((ext_vector_type(8)))short;
using s16x4=__attribute__((ext_vector_type(4)))short;
using f32x16=__attribute__((ext_vector_type(16)))float;
using u32x4=__attribute__((ext_vector_type(4)))unsigned;
constexpr int SEQ=8192,D=64;
constexpr int NW=8,QBLK=32,QB=QBLK*NW,KVBLK=64,NQB=SEQ/QB;
constexpr int ATTN_UNIT_ROWS=QB;
__device__ __forceinline__ int crow(int r,int hi){return (r&3)+8*(r>>2)+4*hi;}
#define SBAR() __builtin_amdgcn_sched_barrier(0)
__device__ __forceinline__ void cmask(f32x16&p0,f32x16&p1,int jb,int qrel,int hi){
  const float NEG=-INFINITY; int kb=64*jb+4*hi;
  #pragma unroll
  for(int r=0;r<16;++r){int kv=kb+(r&3)+8*(r>>2); if(kv>qrel)p0[r]=NEG; if(kv+32>qrel)p1[r]=NEG;}
}

typedef __attribute__((address_space(3))) const float* lds_fptr;
__device__ __forceinline__ void dmask(f32x16&p0,f32x16&p1,lds_fptr tb){
  #pragma unroll
  for(int r=0;r<16;++r){p0[r]+=tb[(r&3)+8*(r>>2)]; p1[r]+=tb[32+(r&3)+8*(r>>2)];}
}
constexpr int NSLOT=3, SLOTB=8192;
constexpr int LDS_K=0, LDS_V=NSLOT*SLOTB, LDS_WS=2*NSLOT*SLOTB, LDS_OST=LDS_WS+NW*64*4, LDS_BYTES=LDS_OST+NW*4096;
constexpr float C2=0.125f*1.4426950408889634f;
__device__ __forceinline__ void glds16(const void*gsrc,unsigned lds_dst){unsigned keep;
  asm volatile("s_mov_b32 %0, m0\n\ts_mov_b32 m0, %2\n\ts_nop 0\n\tglobal_load_lds_dwordx4 %1, off\n\ts_mov_b32 m0, %0":"=&s"(keep):"v"(gsrc),"s"(lds_dst):"memory");}
__device__ __forceinline__ float max3f(float a,float b,float c){float r;asm("v_max3_f32 %0, %1, %2, %3":"=v"(r):"v"(a),"v"(b),"v"(c));return r;}
__device__ __forceinline__ float max2f(float a,float b){float r;asm("v_max_f32_e32 %0, %1, %2":"=v"(r):"v"(a),"v"(b));return r;}
__device__ __forceinline__ float fadd_s(float a,float b){float r;asm("v_add_f32_e32 %0, %1, %2":"=v"(r):"v"(a),"v"(b));return r;}
__device__ __forceinline__ float fsub_s(float a,float b){float r;asm("v_sub_f32_e32 %0, %1, %2":"=v"(r):"v"(a),"v"(b));return r;}
typedef float f32x2_t __attribute__((ext_vector_type(2))); typedef __bf16 bf16x2_t __attribute__((ext_vector_type(2)));
__device__ __forceinline__ unsigned cvtpk_s(float lo,float hi){f32x2_t v={lo,hi};bf16x2_t b=__builtin_convertvector(v,bf16x2_t);return __builtin_bit_cast(unsigned,b);}
#define WAIT_BAR(N) asm volatile("s_waitcnt vmcnt(" #N ") lgkmcnt(0)\n\ts_barrier":::"memory")

__device__ __forceinline__ void qkt(f32x16&p0,f32x16&p1,const char*Kslot,const bf16x8*qr,const f32x16&negm,int r32,int hi){
  const char*kb=Kslot+hi*1024+r32*16;
  #pragma unroll
  for(int d0=0;d0<4;++d0){
    const bf16x8 b0=*reinterpret_cast<const bf16x8*>(kb+d0*2048);
    const bf16x8 b1=*reinterpret_cast<const bf16x8*>(kb+d0*2048+512);
    if(d0==0){p0=__builtin_amdgcn_mfma_f32_32x32x16_bf16(b0,qr[0],negm,0,0,0);p1=__builtin_amdgcn_mfma_f32_32x32x16_bf16(b1,qr[0],negm,0,0,0);}
    else{p0=__builtin_amdgcn_mfma_f32_32x32x16_bf16(b0,qr[d0],p0,0,0,0);p1=__builtin_amdgcn_mfma_f32_32x32x16_bf16(b1,qr[d0],p1,0,0,0);}}
}
typedef __attribute__((address_space(3))) const char* lds_cptr;
typedef short v4i16_t __attribute__((ext_vector_type(4)));
__device__ __forceinline__ void kload8(bf16x8*kf,lds_cptr kp){
  kf[0]=*(const __attribute__((address_space(3))) bf16x8*)(kp);      kf[1]=*(const __attribute__((address_space(3))) bf16x8*)(kp+512);
  kf[2]=*(const __attribute__((address_space(3))) bf16x8*)(kp+2048); kf[3]=*(const __attribute__((address_space(3))) bf16x8*)(kp+2560);
  kf[4]=*(const __attribute__((address_space(3))) bf16x8*)(kp+4096); kf[5]=*(const __attribute__((address_space(3))) bf16x8*)(kp+4608);
  kf[6]=*(const __attribute__((address_space(3))) bf16x8*)(kp+6144); kf[7]=*(const __attribute__((address_space(3))) bf16x8*)(kp+6656);
}
__device__ __forceinline__ void kload2(bf16x8*kf,lds_cptr kp,int j){ kf[2*j]=*(const __attribute__((address_space(3))) bf16x8*)(kp+j*2048); kf[2*j+1]=*(const __attribute__((address_space(3))) bf16x8*)(kp+j*2048+512); }
__device__ __forceinline__ s16x4 vtr(lds_cptr p){ return __builtin_bit_cast(s16x4,__builtin_amdgcn_ds_read_tr16_b64_v4i16((__attribute__((address_space(3))) v4i16_t*)p)); }
__device__ __forceinline__ float rowmax(const f32x16&p0,const f32x16&p1){
  float a=max3f(p0[0],p0[1],p1[0]),b=max3f(p0[2],p0[3],p1[1]);a=max3f(a,p1[2],p1[3]);
  #pragma unroll
  for(int r=4;r<16;r+=4){a=max3f(a,p0[r],p0[r+1]);b=max3f(b,p0[r+2],p0[r+3]);a=max3f(a,p1[r],p1[r+1]);b=max3f(b,p1[r+2],p1[r+3]);}
  const float m=max2f(a,b);
  auto rr=__builtin_amdgcn_permlane32_swap(__float_as_uint(m),__float_as_uint(m),false,false);
  return max2f(__uint_as_float(rr[0]),__uint_as_float(rr[1]));
}
__device__ __forceinline__ void pv(f32x16*o,int vb,bf16x8 pa0,bf16x8 pa1,bf16x8 pa2,bf16x8 pa3){
  #pragma unroll
  for(int d0=0;d0<2;++d0){s16x4 lo[4],hi[4];
    #pragma unroll
    for(int ks=0;ks<4;++ks){
      asm volatile("ds_read_b64_tr_b16 %0,%1 offset:%c2":"=&v"(lo[ks]):"v"(vb),"i"(d0*4096+ks*1024):"memory");
      asm volatile("ds_read_b64_tr_b16 %0,%1 offset:%c2":"=&v"(hi[ks]):"v"(vb),"i"(d0*4096+ks*1024+512):"memory");}
    asm volatile("s_waitcnt lgkmcnt(0)":::"memory");SBAR();
    #define PK(k) (bf16x8){lo[k][0],lo[k][1],lo[k][2],lo[k][3],hi[k][0],hi[k][1],hi[k][2],hi[k][3]}
    o[d0]=__builtin_amdgcn_mfma_f32_32x32x16_bf16(pa0,PK(0),o[d0],0,0,0);
    o[d0]=__builtin_amdgcn_mfma_f32_32x32x16_bf16(pa1,PK(1),o[d0],0,0,0);
    o[d0]=__builtin_amdgcn_mfma_f32_32x32x16_bf16(pa2,PK(2),o[d0],0,0,0);
    o[d0]=__builtin_amdgcn_mfma_f32_32x32x16_bf16(pa3,PK(3),o[d0],0,0,0);
    #undef PK
  }
}

#ifndef ATTN_STORE16
#define ATTN_STORE16(p,v) (*(u32x4*)(p)=(v))
#endif
constexpr int DTBL_OFF=86016, DTBL_N=2560;
template<int THRL,int MODE> __device__ __forceinline__ void attn_unit(const bf16*Qb,const bf16*__restrict__ Kt0,const bf16*__restrict__ Vt0,bf16*Ob,const int pin,const int pout,const int NT,const int kvbase,char*shm){
  const int tid=threadIdx.x,lane=tid&63,r32=lane&31,hi=lane>>5; const int wid=__builtin_amdgcn_readfirstlane(tid>>6);
  const bf16*Qw=Qb+(long)(wid*QBLK)*pin;
  const bf16*Kh=Kt0,*Vh=Vt0;
  const unsigned lds0=(unsigned)(uintptr_t)shm;
  float*wsf=(float*)(shm+LDS_WS)+wid*64;
  const bf16*ksrc=Kh+(long)lane*pin+wid*8;
  const bf16*vsrc=Vh+(long)(16*(wid&3)+(lane>>2))*pin+(wid>>2)*32+(lane&3)*8;
  const unsigned kdst=lds0+LDS_K+wid*1024, vdst=lds0+LDS_V+wid*1024;
  #define DMA_K(t,slot) glds16(ksrc+(long)(t)*KVBLK*pin,(unsigned)__builtin_amdgcn_readfirstlane(kdst+(slot)))
  #define DMA_V(t,slot) glds16(vsrc+(long)(t)*KVBLK*pin,(unsigned)__builtin_amdgcn_readfirstlane(vdst+(slot)))
  const int vb0=(int)(lds0+LDS_V)+((lane>>4)&1)*32+(lane&3)*8+(4*hi+((lane&15)>>2))*64;
  const char*Kbase=shm+LDS_K; bf16x8 kf[8];
  const lds_cptr shm3=(lds_cptr)shm; const lds_cptr kp0=shm3+LDS_K+hi*1024+r32*16; const lds_cptr vp0=shm3+LDS_V+((lane>>4)&1)*32+(lane&3)*8+(4*hi+((lane&15)>>2))*64;
  DMA_K(0,0);DMA_V(0,0);DMA_K(1,SLOTB);
  bf16x8 qr[4];
  #pragma unroll
  for(int d0=0;d0<4;++d0)qr[d0]=*reinterpret_cast<const bf16x8*>(&Qw[(long)r32*pin+d0*16+hi*8]);
  float mhat=0.f,l_reg=0.f;f32x16 o[2];o[0]=f32x16{};o[1]=f32x16{};f32x16 negm=f32x16{};asm volatile("":"+v"(negm));
  const int qrel=wid*QBLK+r32;
  const lds_fptr dtb=(lds_fptr)(shm3+DTBL_OFF)+(kvbase+4*hi-qrel+1280);
  #define CMASK(P0,P1,t) do{ if(MODE==1) dmask(P0,P1,dtb+64*(t)); }while(0)
  bool resc=false;
  #define START(P0,P1) do{ const float rm=rowmax(P0,P1); resc=false; \
    { const float dl=rm; mhat=fadd_s(mhat,dl); \
      _Pragma("unroll") for(int r=0;r<16;++r){P0[r]=fsub_s(P0[r],dl);P1[r]=fsub_s(P1[r],dl);} \
      _Pragma("unroll") for(int r=0;r<16;++r)negm[r]=-mhat; asm volatile("":"+v"(negm)); } \
    _Pragma("unroll") for(int r=0;r<16;++r)P0[r]=__builtin_amdgcn_exp2f(P0[r]); }while(0)
  #define RESC() do{ if(resc){ asm volatile("s_waitcnt lgkmcnt(0)":::"memory"); \
      _Pragma("unroll") for(int d_=0;d_<2;++d_) _Pragma("unroll") for(int r=0;r<16;++r)o[d_][r]*=wsf[crow(r,hi)]; } }while(0)
  f32x16 pA0,pA1,pB0,pB1;
  int sl_prev=0,sl_cur=0,sl_next=SLOTB;
  #define ROT() do{sl_prev=sl_cur;sl_cur=sl_next;sl_next=(sl_next==(NSLOT-1)*SLOTB)?0:sl_next+SLOTB;}while(0)
  DMA_K(2,2*SLOTB);
  WAIT_BAR(3);
  qkt(pA0,pA1,Kbase,qr,negm,r32,hi);asm volatile("s_nop 15\n\ts_nop 7":"+v"(pA0),"+v"(pA1));CMASK(pA0,pA1,0);
  START(pA0,pA1);
  _Pragma("unroll") for(int r=0;r<16;++r)pA1[r]=__builtin_amdgcn_exp2f(pA1[r]);
  WAIT_BAR(0);
  DMA_K(3,0);DMA_V(1,SLOTB);
  ROT();
  kload8(kf,kp0+sl_cur);
  WAIT_BAR(2);
  s16x4 vlo[8],vhi[8]; u32x4 pw0,pw1,pw2,pw3;
  #define PKW(P,B) cvtpk_s(P[B],P[B+1])
  #define PAF(k) __builtin_bit_cast(bf16x8,pw##k)
  #define VFR(i) (bf16x8){vlo[i][0],vlo[i][1],vlo[i][2],vlo[i][3],vhi[i][0],vhi[i][1],vhi[i][2],vhi[i][3]}
  #define PIN(x) asm volatile("":"+v"(x))
  #define MX3(a,b,c) __builtin_fmaxf(__builtin_fmaxf((a),(b)),(c))
  #define GAPA(MF,A0,A1,A2,A3,W0,W1,PW) do{ MF; sacc+=A0; sacc+=A1; sacc+=A2; sacc+=A3; PIN(sacc); W0; W1; PIN(PW); SBAR(); }while(0)
  #define EX(v) __builtin_amdgcn_exp2f(v)
  #define GAPB(MF,X,B) do{ MF; X[B]=EX(X[B]); X[B+1]=EX(X[B+1]); X[B+2]=EX(X[B+2]); X[B+3]=EX(X[B+3]); PIN(X); SBAR(); }while(0)
  #define VRD(i) do{ vlo[i]=vtr(vp_+(((i)>>2)*4096+((i)&3)*1024)); vhi[i]=vtr(vp_+(((i)>>2)*4096+((i)&3)*1024+512)); }while(0)
  #define KRD(G,j) do{ if(G){ kload2(kf,kp0+sl_next,j); SBAR(); } }while(0)
  #define STEP(C0,C1,P0,P1,t,GK,GV,GL) do{ SBAR(); \
    const lds_cptr vp_=vp0+sl_prev; \
    VRD(0); SBAR(); float sacc=(P0[0]+P0[1]); \
    GAPA(C0=__builtin_amdgcn_mfma_f32_32x32x16_bf16(kf[0],qr[0],negm,0,0,0), P0[2],P0[3],P0[4],P0[5],     pw0[0]=PKW(P0,0), pw0[1]=PKW(P0,2), pw0); \
    VRD(4); SBAR(); GAPA(C1=__builtin_amdgcn_mfma_f32_32x32x16_bf16(kf[1],qr[0],negm,0,0,0), P0[6],P0[7],P0[8],P0[9],     pw0[2]=PKW(P0,4), pw0[3]=PKW(P0,6), pw0); \
    VRD(1); SBAR(); GAPA(C0=__builtin_amdgcn_mfma_f32_32x32x16_bf16(kf[2],qr[1],C0,0,0,0),   P0[10],P0[11],P0[12],P0[13], pw1[0]=PKW(P0,8), pw1[1]=PKW(P0,10), pw1); \
    VRD(5); SBAR(); GAPA(C1=__builtin_amdgcn_mfma_f32_32x32x16_bf16(kf[3],qr[1],C1,0,0,0),   P0[14],P0[15],P1[0],P1[1],   pw1[2]=PKW(P0,12),pw1[3]=PKW(P0,14), pw1); \
    VRD(2); SBAR(); GAPA(C0=__builtin_amdgcn_mfma_f32_32x32x16_bf16(kf[4],qr[2],C0,0,0,0),   P1[2],P1[3],P1[4],P1[5],     pw2[0]=PKW(P1,0), pw2[1]=PKW(P1,2), pw2); \
    VRD(6); SBAR(); GAPA(C1=__builtin_amdgcn_mfma_f32_32x32x16_bf16(kf[5],qr[2],C1,0,0,0),   P1[6],P1[7],P1[8],P1[9],     pw2[2]=PKW(P1,4), pw2[3]=PKW(P1,6), pw2); \
    VRD(3); SBAR(); GAPA(C0=__builtin_amdgcn_mfma_f32_32x32x16_bf16(kf[6],qr[3],C0,0,0,0),   P1[10],P1[11],P1[12],P1[13], pw3[0]=PKW(P1,8), pw3[1]=PKW(P1,10), pw3); \
    VRD(7); SBAR(); GAPA(C1=__builtin_amdgcn_mfma_f32_32x32x16_bf16(kf[7],qr[3],C1,0,0,0),   P1[14],P1[15],0.f,0.f,       pw3[2]=PKW(P1,12),pw3[3]=PKW(P1,14), pw3); \
    l_reg+=sacc; \
    if(GK){DMA_K((t)+3,sl_cur);} if(GV){DMA_V((t)+1,sl_next);} \
    CMASK(C0,C1,t); \
    { float a=MX3(C0[0],C0[1],C1[0]),b=MX3(C0[2],C0[3],C1[1]); a=MX3(a,C1[2],C1[3]); \
      _Pragma("unroll") for(int r=4;r<16;r+=4){a=MX3(a,C0[r],C0[r+1]);b=MX3(b,C0[r+2],C0[r+3]);a=MX3(a,C1[r],C1[r+1]);b=MX3(b,C1[r+2],C1[r+3]);} \
      float rm=__builtin_fmaxf(a,b); { auto rr=__builtin_amdgcn_permlane32_swap(__float_as_uint(rm),__float_as_uint(rm),false,false); rm=__builtin_fmaxf(__uint_as_float(rr[0]),__uint_as_float(rr[1])); } \
      resc=false; \
      if(__builtin_expect(__any(rm>(float)THRL),0)){ const float dl=__builtin_fmaxf(rm,0.f); mhat+=dl; \
        _Pragma("unroll") for(int r=0;r<16;++r){C0[r]-=dl;C1[r]-=dl;} \
        _Pragma("unroll") for(int r=0;r<16;++r)negm[r]=-mhat; asm volatile("":"+v"(negm)); \
        const float f=__builtin_amdgcn_exp2f(-dl); l_reg*=f; if(hi==0)wsf[r32]=f; resc=true; } } \
    SBAR(); \
    GAPB(o[0]=__builtin_amdgcn_mfma_f32_32x32x16_bf16(PAF(0),VFR(0),o[0],0,0,0), C0,0); \
    GAPB(o[1]=__builtin_amdgcn_mfma_f32_32x32x16_bf16(PAF(0),VFR(4),o[1],0,0,0), C0,4); \
    KRD(GL,0); GAPB(o[0]=__builtin_amdgcn_mfma_f32_32x32x16_bf16(PAF(1),VFR(1),o[0],0,0,0), C0,8); \
    KRD(GL,1); GAPB(o[1]=__builtin_amdgcn_mfma_f32_32x32x16_bf16(PAF(1),VFR(5),o[1],0,0,0), C0,12); \
    KRD(GL,2); GAPB(o[0]=__builtin_amdgcn_mfma_f32_32x32x16_bf16(PAF(2),VFR(2),o[0],0,0,0), C1,0); \
    KRD(GL,3); GAPB(o[1]=__builtin_amdgcn_mfma_f32_32x32x16_bf16(PAF(2),VFR(6),o[1],0,0,0), C1,4); \
    GAPB(o[0]=__builtin_amdgcn_mfma_f32_32x32x16_bf16(PAF(3),VFR(3),o[0],0,0,0), C1,8); \
    GAPB(o[1]=__builtin_amdgcn_mfma_f32_32x32x16_bf16(PAF(3),VFR(7),o[1],0,0,0), C1,12); \
    }while(0)
  int t=1;
  for(;t+5<NT;t+=2){
    STEP(pB0,pB1,pA0,pA1,t,true,true,true);     WAIT_BAR(2); RESC(); ROT();
    STEP(pA0,pA1,pB0,pB1,t+1,true,true,true);   WAIT_BAR(2); RESC(); ROT();
  }
  #define ENDW(tt) do{ if((tt)+3<NT){WAIT_BAR(2);} else if((tt)+2<NT){WAIT_BAR(1);} else {WAIT_BAR(0);} }while(0)
  for(;t+1<NT;t+=2){
    STEP(pB0,pB1,pA0,pA1,t,(t+3<NT),(t+1<NT),(t+1<NT));       ENDW(t);   RESC(); ROT();
    STEP(pA0,pA1,pB0,pB1,t+1,(t+4<NT),(t+2<NT),(t+2<NT));     ENDW(t+1); RESC(); ROT();
  }
  STEP(pB0,pB1,pA0,pA1,NT-1,false,false,false); RESC();
  { float sacc=pB0[0]+pB0[1]; _Pragma("unroll") for(int r=2;r<16;++r)sacc+=pB0[r]; _Pragma("unroll") for(int r=0;r<16;++r)sacc+=pB1[r]; l_reg+=sacc;
    pw0=(u32x4){PKW(pB0,0),PKW(pB0,2),PKW(pB0,4),PKW(pB0,6)};pw1=(u32x4){PKW(pB0,8),PKW(pB0,10),PKW(pB0,12),PKW(pB0,14)};pw2=(u32x4){PKW(pB1,0),PKW(pB1,2),PKW(pB1,4),PKW(pB1,6)};pw3=(u32x4){PKW(pB1,8),PKW(pB1,10),PKW(pB1,12),PKW(pB1,14)};
    SBAR(); pv(o,vb0+sl_cur,PAF(0),PAF(1),PAF(2),PAF(3)); }
  #undef PKW
  #undef PAF
  #undef VFR
  #undef PIN
  #undef MX3
  #undef GAPA
  #undef GAPB
  #undef EX
  #undef VRD
  #undef KRD
  #undef STEP
  #undef ENDW
  {auto rr=__builtin_amdgcn_permlane32_swap(__float_as_uint(l_reg),__float_as_uint(l_reg),false,false);l_reg=__uint_as_float(rr[0])+__uint_as_float(rr[1]);}
  if(hi==0)wsf[32+r32]=l_reg;asm volatile("s_waitcnt lgkmcnt(0)":::"memory");
  float rli[16];
  #pragma unroll
  for(int r=0;r<16;++r)rli[r]=__builtin_amdgcn_rcpf(wsf[32+crow(r,hi)]);
  bf16*Ow=Ob+(long)(wid*QBLK)*pout;
  { bf16*stg=(bf16*)(shm+LDS_OST)+wid*2048;
    #pragma unroll
    for(int r=0;r<16;++r){const int orow=crow(r,hi);
      #pragma unroll
      for(int d0=0;d0<2;++d0)stg[orow*64+d0*32+r32]=__float2bfloat16(o[d0][r]*rli[r]);}
    asm volatile("s_waitcnt lgkmcnt(0)":::"memory");
    #pragma unroll
    for(int i=0;i<4;++i){const int row=i*8+(lane>>3),ch=lane&7; const u32x4 v=*(const u32x4*)(stg+row*64+ch*8); ATTN_STORE16(Ow+(long)row*pout+ch*8,v);} }
  asm volatile("s_waitcnt lgkmcnt(0)\n\ts_barrier":::"memory");
  #undef DMA_K
  #undef DMA_V
  #undef CMASK
  #undef START
  #undef RESC
  #undef ROT
}
constexpr int ATTN_LDS_BYTES=LDS_BYTES;
#undef SBAR
#undef WAIT_BAR
}
constexpr int NWAVES = 8;
constexpr int SEQ = 8192, NBATCH = 2, M = NBATCH * SEQ, D = 1024, FF = 2816, NI0 = 2304, NI1 = 3072;
constexpr float RMS_EPS = 1e-6f, LAM_INIT = 0.35550906f;
constexpr size_t MiB = 1u << 20;
constexpr size_t WS_CTL = 0, CTL_ZERO_BYTES = 1 * MiB;
constexpr size_t WS_SS = 512 * 1024;
constexpr size_t WS_WIN0 = 2 * MiB, WS_WO0 = WS_WIN0 + (size_t)NI0 * D * 2, WS_WIN1 = WS_WO0 + (size_t)D * D * 2, WS_WO1 = WS_WIN1 + (size_t)NI1 * D * 2,
                 WS_WGU0 = WS_WO1 + (size_t)D * D * 2, WS_WGU1 = WS_WGU0 + (size_t)2 * FF * D * 2, WS_WD0 = WS_WGU1 + (size_t)2 * FF * D * 2,
                 WS_WD1 = WS_WD0 + (size_t)FF * D * 2, WS_WEND = WS_WD1 + (size_t)FF * D * 2;
static_assert(WS_WEND <= 50 * MiB, "weights");
constexpr size_t WS_TAB = 50 * MiB;
constexpr size_t WS_XB = 64 * MiB, WS_PROJ = 96 * MiB, WS_H = 96 * MiB, WS_OC = 96 * MiB, WS_O = 192 * MiB, WS_END = 256 * MiB;
constexpr int CW_TMO = 0, CW_CODE = 1, CW_BAR = 4096;
constexpr int RING_OFF = 0, RING_BYTES = 131072;
constexpr int LDSCTL_OFF = RING_BYTES, MISC_OFF = LDSCTL_OFF + 320;
constexpr int LDS_BYTES = 147456;

#define GAS __attribute__((address_space(1)))
#define LAS __attribute__((address_space(3)))
typedef unsigned short bf16;
typedef unsigned v4u __attribute__((ext_vector_type(4)));
typedef float f32x4 __attribute__((ext_vector_type(4)));
typedef short bf16x8 __attribute__((ext_vector_type(8)));
typedef GAS unsigned gu32;
typedef GAS unsigned long long gu64;
#define RLX_AGENT __ATOMIC_RELAXED, __HIP_MEMORY_SCOPE_AGENT
#define LDS_WAIT() asm volatile("s_waitcnt lgkmcnt(0)" ::: "memory")
#define VM_WAIT() asm volatile("s_waitcnt vmcnt(0)" ::: "memory")
__device__ __forceinline__ unsigned long long rt() { return __builtin_amdgcn_s_memrealtime(); }
__device__ __forceinline__ unsigned f2bf(float f) { unsigned u = __builtin_bit_cast(unsigned, f); return (u + 0x7fffu + ((u >> 16) & 1u)) >> 16; }
__device__ __forceinline__ unsigned pk2(float lo, float hi) { return f2bf(lo) | (f2bf(hi) << 16); }

#define XB_TMO      128
#define XB_XCNT(j)  (256  + 64 * (j))
#define XB_XSUB(j)  (1280 + 64 * (j))
#define XB_XGEN(j)  (2304 + 64 * (j))
#define XB_TOP      3328
#define XB_TOPGEN   3392
#define XCD_BAR_WORDS 3456
#define XB_SPIN_CAP (1u << 18)

__device__ __forceinline__ unsigned xb_ld(unsigned* p)              { return __hip_atomic_load(p, __ATOMIC_RELAXED, __HIP_MEMORY_SCOPE_AGENT); }
__device__ __forceinline__ unsigned xb_add(unsigned* p, unsigned v) { return __hip_atomic_fetch_add(p, v, __ATOMIC_RELAXED, __HIP_MEMORY_SCOPE_AGENT); }
__device__ __forceinline__ unsigned xb_xcc_id() { return (unsigned)__builtin_amdgcn_s_getreg((3 << 11) | 20) & 0xFu; }
#define XB_SPIN(cond, bar) do { unsigned _sp = 0; while (cond) { __builtin_amdgcn_s_sleep(1); \
    if ((++_sp & 255u) == 0u) { if (xb_ld(&(bar)[XB_TMO])) break; if (_sp > XB_SPIN_CAP) { atomicAdd(&(bar)[XB_TMO], 1u); break; } } } } while (0)

struct XcdBarrier {
    unsigned* bar; unsigned x;
    volatile LAS unsigned* st;
};

__device__ __forceinline__ XcdBarrier xcd_barrier_post(unsigned* bar, volatile LAS unsigned* st) {
    XcdBarrier b; b.bar = bar; b.x = xb_xcc_id(); b.st = st;
    if (threadIdx.x == 0) (void)xb_add(&bar[XB_XCNT(b.x)], 1u);
    return b;
}
__device__ __forceinline__ void xcd_barrier_complete(unsigned* bar, unsigned x, unsigned& nloc, unsigned& nx) {
    const unsigned G = gridDim.x * gridDim.y * gridDim.z;
    unsigned sum, cnt, mine, sp = 0u;
    for (;;) {
        sum = 0u; cnt = 0u; mine = 0u;
#pragma unroll
        for (unsigned j = 0; j < 16; ++j) { const unsigned c = xb_ld(&bar[XB_XCNT(j)]); sum += c; cnt += (c > 0u) ? 1u : 0u; mine = (j == x) ? c : mine; }
        if (sum == G) break;
        __builtin_amdgcn_s_sleep(1);
        if ((++sp & 255u) == 0u) { if (xb_ld(&bar[XB_TMO])) break; if (sp > XB_SPIN_CAP) { atomicAdd(&bar[XB_TMO], 1u); break; } }
    }
    nloc = mine > 0u ? mine : 1u; nx = cnt > 0u ? cnt : 1u;
}

__device__ __forceinline__ void xcd_barrier(const XcdBarrier& b) {
    asm volatile("s_waitcnt vmcnt(0)" ::: "memory");
    __syncthreads();
    if (threadIdx.x == 0) {
        unsigned* bar = b.bar;
        __builtin_amdgcn_s_waitcnt(0);
        unsigned nloc = b.st[0], nx = b.st[1];
        if (nloc == 0u) { xcd_barrier_complete(bar, b.x, nloc, nx); b.st[0] = nloc; b.st[1] = nx; }
        const unsigned old = xb_add(&bar[XB_XSUB(b.x)], 1u);
        const unsigned gen = old / nloc;
        if (old + 1u == (gen + 1u) * nloc) {
            __builtin_amdgcn_fence(__ATOMIC_RELEASE, "agent");
            asm volatile("s_waitcnt vmcnt(0)" ::: "memory");
            const unsigned og = xb_add(&bar[XB_TOP], 1u);
            const unsigned tg = og / nx;
            if (og + 1u == (tg + 1u) * nx) xb_add(&bar[XB_TOPGEN], 1u);
            else XB_SPIN(xb_ld(&bar[XB_TOPGEN]) == tg, bar);
            __builtin_amdgcn_fence(__ATOMIC_ACQUIRE, "agent");
            xb_add(&bar[XB_XGEN(b.x)], 1u);
            asm volatile("s_waitcnt vmcnt(0)" ::: "memory");
        } else {
            XB_SPIN(xb_ld(&bar[XB_XGEN(b.x)]) == gen, bar);
            __builtin_amdgcn_fence(__ATOMIC_ACQUIRE, "agent");
            asm volatile("s_waitcnt vmcnt(0)" ::: "memory");
        }
    }
    __syncthreads();
}
struct Frame {
    LAS unsigned char* lds;
    volatile LAS unsigned* MISC;
    gu32* ctl;
    int tid, lane, wave;
    int vcu, G;
    const float* in[18]; float* out; unsigned char* ws;
};
__device__ __forceinline__ float wave_sum(float v) {
#pragma unroll
    for (int o = 1; o < 64; o <<= 1) v += __shfl_xor(v, o);
    return v;
}
__device__ __forceinline__ float bf2f(unsigned b) { return __uint_as_float(b << 16); }
__device__ __forceinline__ void p0_transpose_item(const float* W, const float* gain, int K, int N, bf16* WT, int kb, int nb, int dst_row0, LAS float* scr, int lane) {
    const int k0 = 64 * kb, n0 = 32 * nb;
#pragma unroll 8
    for (int i = 0; i < 32; ++i) { const int kk = 2 * i + (lane >> 5); float w = W[(size_t)(k0 + kk) * N + n0 + (lane & 31)]; if (gain) w *= gain[k0 + kk]; scr[kk * 33 + (lane & 31)] = w; }
    LDS_WAIT(); asm volatile("" ::: "memory");
    const int c = lane & 7;
#pragma unroll
    for (int j = 0; j < 4; ++j) { const int n = (lane >> 3) + 8 * j; const LAS float* s = scr + (8 * c) * 33 + n;
        v4u o; o.x = pk2(s[0 * 33], s[1 * 33]); o.y = pk2(s[2 * 33], s[3 * 33]); o.z = pk2(s[4 * 33], s[5 * 33]); o.w = pk2(s[6 * 33], s[7 * 33]);
        *(GAS v4u*)(WT + (size_t)(dst_row0 + n) * K + k0 + 8 * c) = o; }
    LDS_WAIT(); asm volatile("" ::: "memory");
}
__device__ __forceinline__ void cvt_rows(Frame& F, const float* src, bf16* XB, float* ss) {
    const int gw = F.vcu * NWAVES + F.wave, NGW = F.G * NWAVES;
    for (int m = gw; m < M; m += NGW) {
        const GAS f32x4* xr = (const GAS f32x4*)(src + (size_t)m * D) + F.lane;
        f32x4 v[4]; float s = 0.f;
#pragma unroll
        for (int j = 0; j < 4; ++j) { v[j] = xr[64 * j]; s += (v[j].x * v[j].x + v[j].y * v[j].y) + (v[j].z * v[j].z + v[j].w * v[j].w); }
        s = wave_sum(s);
        GAS unsigned long long* o8 = (GAS unsigned long long*)(XB + (size_t)m * D) + F.lane;
#pragma unroll
        for (int j = 0; j < 4; ++j) o8[64 * j] = (unsigned long long)pk2(v[j].x, v[j].y) | ((unsigned long long)pk2(v[j].z, v[j].w) << 32);
        if (F.lane == 0) ss[m] = s;
    }
}
__device__ __forceinline__ void p0_prologue(Frame& F) {
    LAS float* scr = (LAS float*)(F.lds + RING_OFF + F.wave * 16384);
    const int gw = F.vcu * NWAVES + F.wave, NGW = F.G * NWAVES;
    constexpr int I_IN0 = 16 * (NI0 / 32), I_O = 16 * (D / 32), I_IN1 = 16 * (NI1 / 32), I_G = 16 * (FF / 32), I_D = (FF / 64) * (D / 32);
    constexpr int NITEMS = I_IN0 + I_O + I_IN1 + I_O + 2 * (2 * I_G + I_D);
    const float* attn_norm = F.in[1]; const float* ffn_norm = F.in[2];
    for (int it = gw; it < NITEMS; it += NGW) {
        int r = it;
        if (r < I_IN0) { const int nbk = NI0 / 32; p0_transpose_item(F.in[4], attn_norm, D, NI0, (bf16*)(F.ws + WS_WIN0), r / nbk, r % nbk, 32 * (r % nbk), scr, F.lane); continue; } r -= I_IN0;
        if (r < I_O) { const int nbk = D / 32; p0_transpose_item(F.in[7], nullptr, D, D, (bf16*)(F.ws + WS_WO0), r / nbk, r % nbk, 32 * (r % nbk), scr, F.lane); continue; } r -= I_O;
        if (r < I_IN1) { const int nbk = NI1 / 32; p0_transpose_item(F.in[8], attn_norm + D, D, NI1, (bf16*)(F.ws + WS_WIN1), r / nbk, r % nbk, 32 * (r % nbk), scr, F.lane); continue; } r -= I_IN1;
        if (r < I_O) { const int nbk = D / 32; p0_transpose_item(F.in[14], nullptr, D, D, (bf16*)(F.ws + WS_WO1), r / nbk, r % nbk, 32 * (r % nbk), scr, F.lane); continue; } r -= I_O;
        const int l = r / (2 * I_G + I_D); r -= l * (2 * I_G + I_D);
        if (r < 2 * I_G) { const int up = r / I_G; r -= up * I_G; const int nbk = FF / 32, nb = r % nbk, n0 = 32 * nb;
            p0_transpose_item((up ? F.in[16] : F.in[15]) + (size_t)l * D * FF, ffn_norm + l * D, D, FF, (bf16*)(F.ws + (l ? WS_WGU1 : WS_WGU0)), r / nbk, nb, (n0 / 128) * 256 + (n0 % 128) + up * 128, scr, F.lane); continue; }
        r -= 2 * I_G;
        { const int nbk = D / 32; p0_transpose_item(F.in[17] + (size_t)l * FF * D, nullptr, FF, D, (bf16*)(F.ws + (l ? WS_WD1 : WS_WD0)), r / nbk, r % nbk, 32 * (r % nbk), scr, F.lane); }
    }
    { float* tab = (float*)(F.ws + WS_TAB); const int gt = (F.vcu * NWAVES + F.wave) * 64 + F.lane, NGT = F.G * NWAVES * 64;
      for (int idx = gt; idx < SEQ * 32; idx += NGT) { const int t = idx >> 5, i = idx & 31;
          const float a1 = (float)t * powf(10000.f, -(float)(2 * i) / 64.f);
          const float a2 = (float)(i < 16 ? (t >> 6) : (t & 63)) * powf(10000.f, -(float)(2 * (i & 15)) / 32.f);
          float s1, c1, s2, c2; sincosf(a1, &s1, &c1); sincosf(a2, &s2, &c2);
          tab[idx] = c1; tab[SEQ * 32 + idx] = s1; tab[2 * SEQ * 32 + idx] = c2; tab[3 * SEQ * 32 + idx] = s2; } }
    cvt_rows(F, F.in[0], (bf16*)(F.ws + WS_XB), (float*)(F.ws + WS_SS));
}
template <int LAYER> __device__ __forceinline__ void rope_phase(Frame& F) {
    constexpr int pitch = LAYER == 0 ? NI0 : NI1, NIT = LAYER == 0 ? 9 : 8;
    const float* tab = (const float*)(F.ws + WS_TAB);
    const float* qn = F.in[5]; const float* kn = F.in[6];
    bf16* P = (bf16*)(F.ws + WS_PROJ);
    const int gw = F.vcu * NWAVES + F.wave, NGW = F.G * NWAVES;
    const int sub = F.lane >> 4, d0 = (F.lane & 15) * 4, i0 = d0 & 31;
    f32x4 gq = (f32x4){1.f, 1.f, 1.f, 1.f}, gk = gq;
    if (LAYER == 0) { gq = *(const f32x4*)(qn + d0); gk = *(const f32x4*)(kn + d0); }
    for (int row = gw; row < M; row += NGW) {
        const int t = row & (SEQ - 1);
        const f32x4 c1 = *(const f32x4*)(tab + t * 32 + i0), s1 = *(const f32x4*)(tab + SEQ * 32 + t * 32 + i0);
        f32x4 c2 = c1, s2 = s1;
        if (LAYER == 0) { c2 = *(const f32x4*)(tab + 2 * SEQ * 32 + t * 32 + i0); s2 = *(const f32x4*)(tab + 3 * SEQ * 32 + t * 32 + i0); }
        bf16* prow = P + (size_t)row * pitch;
#pragma unroll
        for (int it = 0; it < NIT; ++it) {
            const int head = it * 4 + sub;
            int mode; float scale = 1.f;
            if (LAYER == 0) { mode = head < 8 ? 2 : head < 10 ? 3 : head < 12 ? 0 : head < 28 ? 1 : 0; if (head < 8 || (head >= 12 && head < 20)) scale = attn_body::C2; }
            else { mode = 1; if (head < 16) scale = attn_body::C2; }
            GAS unsigned long long* pp = (GAS unsigned long long*)(prow + head * 64 + d0);
            const unsigned long long raw = *pp;
            f32x4 y = (f32x4){bf2f((unsigned)raw & 0xffffu), bf2f(((unsigned)raw >> 16) & 0xffffu), bf2f((unsigned)(raw >> 32) & 0xffffu), bf2f((unsigned)(raw >> 48) & 0xffffu)};
            if (LAYER == 0) { float q = (y.x * y.x + y.y * y.y) + (y.z * y.z + y.w * y.w);
                q += __shfl_xor(q, 1); q += __shfl_xor(q, 2); q += __shfl_xor(q, 4); q += __shfl_xor(q, 8);
                const float r = rsqrtf(q * (1.f / 64.f) + RMS_EPS);
                if (mode == 2) y = y * r * gq; else if (mode == 3) y = y * r * gk; }
            const f32x4 c = (mode == 1) ? c1 : c2, s = (mode == 1) ? s1 : s2;
            f32x4 o; o.x = __shfl_xor(y.x, 8); o.y = __shfl_xor(y.y, 8); o.z = __shfl_xor(y.z, 8); o.w = __shfl_xor(y.w, 8);
            const f32x4 res = ((d0 < 32) ? (y * c - o * s) : (o * s + y * c)) * scale;
            if (mode) *pp = (unsigned long long)pk2(res.x, res.y) | ((unsigned long long)pk2(res.z, res.w) << 32);
        }
    }
}
__device__ __forceinline__ void combine_phase(Frame& F) {
    const int gw = F.vcu * NWAVES + F.wave, NGW = F.G * NWAVES;
    const float sa = wave_sum(F.in[9][F.lane] * F.in[10][F.lane]), sb = wave_sum(F.in[11][F.lane] * F.in[12][F.lane]);
    const float lam = expf(sa) - expf(sb) + LAM_INIT;
    const float* gs = F.in[13] + (F.lane & 7) * 16;
    const f32x4 g0 = *(const f32x4*)(gs), g1 = *(const f32x4*)(gs + 4), g2 = *(const f32x4*)(gs + 8), g3 = *(const f32x4*)(gs + 12);
    const bf16* O2 = (const bf16*)(F.ws + WS_O); bf16* OC = (bf16*)(F.ws + WS_OC);
    for (int row = gw; row < M; row += NGW) {
        const GAS v4u* p1 = (const GAS v4u*)(O2 + (size_t)row * 2048 + F.lane * 16); const GAS v4u* p2 = (const GAS v4u*)(O2 + (size_t)row * 2048 + 1024 + F.lane * 16);
        const v4u a0 = p1[0], a1 = p1[1], b0 = p2[0], b1 = p2[1];
        float o[16];
#pragma unroll
        for (int j = 0; j < 4; ++j) { o[2 * j] = bf2f(a0[j] & 0xffffu) - lam * bf2f(b0[j] & 0xffffu); o[2 * j + 1] = bf2f(a0[j] >> 16) - lam * bf2f(b0[j] >> 16);
                                      o[8 + 2 * j] = bf2f(a1[j] & 0xffffu) - lam * bf2f(b1[j] & 0xffffu); o[8 + 2 * j + 1] = bf2f(a1[j] >> 16) - lam * bf2f(b1[j] >> 16); }
        float q = 0.f;
#pragma unroll
        for (int j = 0; j < 16; ++j) q += o[j] * o[j];
        q += __shfl_xor(q, 1); q += __shfl_xor(q, 2); q += __shfl_xor(q, 4);
        const float r = rsqrtf(q * (1.f / 128.f) + RMS_EPS) * (1.0f - LAM_INIT);
        v4u w0, w1;
        w0.x = pk2(o[0] * r * g0.x, o[1] * r * g0.y); w0.y = pk2(o[2] * r * g0.z, o[3] * r * g0.w); w0.z = pk2(o[4] * r * g1.x, o[5] * r * g1.y); w0.w = pk2(o[6] * r * g1.z, o[7] * r * g1.w);
        w1.x = pk2(o[8] * r * g2.x, o[9] * r * g2.y); w1.y = pk2(o[10] * r * g2.z, o[11] * r * g2.w); w1.z = pk2(o[12] * r * g3.x, o[13] * r * g3.y); w1.w = pk2(o[14] * r * g3.z, o[15] * r * g3.w);
        GAS v4u* po = (GAS v4u*)(OC + (size_t)row * 1024 + F.lane * 16); po[0] = w0; po[1] = w1;
    }
}
__device__ __forceinline__ void final_norm_phase(Frame& F) {
    const int gw = F.vcu * NWAVES + F.wave, NGW = F.G * NWAVES;
    const float* ss = (const float*)(F.ws + WS_SS) + 4 * M; const GAS f32x4* g = (const GAS f32x4*)F.in[3] + F.lane;
    for (int m = gw; m < M; m += NGW) {
        const float r = rsqrtf(ss[m] * (1.f / 1024.f) + RMS_EPS);
        GAS f32x4* xr = (GAS f32x4*)(F.out + (size_t)m * D) + F.lane;
#pragma unroll
        for (int j = 0; j < 4; ++j) xr[64 * j] = xr[64 * j] * r * g[64 * j];
    }
}
template <int LAYER> __device__ __forceinline__ void attention_phase(Frame& F, char* lds) {
    using abf = attn_body::bf16;
    const abf* P = (const abf*)(F.ws + WS_PROJ); abf* O = (abf*)(F.ws + WS_O);
    if (LAYER == 0) {
        LAS float* tb = (LAS float*)(F.lds + attn_body::DTBL_OFF);
        for (int idx = F.tid; idx < attn_body::DTBL_N; idx += NWAVES * 64) { const int off = idx - 1280, ao = off < 0 ? -off : off;
            const int mm = (ao <= 64 ? 1 : 0) + ((((off & 3) == 0) && ao <= 256) ? 1 : 0) + ((((off & 15) == 0) && ao <= 1024) ? 1 : 0);
            tb[idx] = mm == 0 ? -1000.f : (mm == 1 ? 0.f : (mm == 2 ? 1.f : 1.5849625007f)); }
        __syncthreads();
        for (int i = 0;; ++i) { const int U = i * F.G + F.vcu; if (U >= 1024) break;
            const int ii = U >> 8, v = U & 255, bh = v >> 4, s = v & 15, b = bh >> 3, h = bh & 7, qb = (ii & 1) ? 31 - s : s, q0 = qb * 256; const size_t rowb = (size_t)b * SEQ;
            if (ii < 2) attn_body::attn_unit<8, 0>(P + (rowb + q0) * NI0 + h * 64, P + rowb * NI0 + 512 + (h >> 2) * 64, P + rowb * NI0 + 640 + (h >> 2) * 64, O + (rowb + q0) * 1024 + h * 64, NI0, 1024, 128, 0, lds);
            else { const int tlo = (q0 - 1024 < 0 ? 0 : q0 - 1024) / 64, thi = (q0 + 1280 > SEQ ? SEQ : q0 + 1280) / 64;
                attn_body::attn_unit<8, 1>(P + (rowb + q0) * NI0 + 768 + h * 64, P + (rowb + 64 * tlo) * NI0 + 1280 + h * 64, P + (rowb + 64 * tlo) * NI0 + 1792 + h * 64, O + (rowb + q0) * 1024 + 512 + h * 64, NI0, 1024, thi - tlo, 64 * tlo - q0, lds); } }
    } else {
        for (int i = 0;; ++i) { const int U = i * F.G + F.vcu; if (U >= 2048) break;
            const int ii = U >> 8, v = U & 255, bj = v >> 2, b = bj >> 5, jj = bj & 31, sid = jj >> 4, h = (jj & 15) >> 1, half = jj & 1, qb = (v & 3) + 4 * ii, q0 = qb * 256; const size_t rowb = (size_t)b * SEQ;
            attn_body::attn_unit<8, 0>(P + (rowb + q0) * NI1 + h * 128 + sid * 64, P + rowb * NI1 + 1024 + h * 128 + sid * 64, P + rowb * NI1 + 2048 + h * 128 + half * 64,
                                       O + (rowb + q0) * 2048 + sid * 1024 + h * 128 + half * 64, NI1, 2048, 128, 0, lds); }
    }
}

struct Args { const float* in[18]; float* out; unsigned char* ws; int ph_lo, ph_hi, li, cvt_ss; };
__global__ void __launch_bounds__(NWAVES * 64, 2) mk_fwd(Args args) {
    extern __shared__ __attribute__((aligned(16))) unsigned char lds[];
    Frame F;
    F.lds = (LAS unsigned char*)lds;
    F.MISC = (volatile LAS unsigned*)(F.lds + MISC_OFF);
    F.tid = threadIdx.x; F.lane = F.tid & 63; F.wave = __builtin_amdgcn_readfirstlane(F.tid >> 6);
    F.G = gridDim.x; { const int bx = blockIdx.x; F.vcu = (F.G % 8 == 0) ? (bx % 8) * (F.G / 8) + bx / 8 : bx; }
    unsigned char* ws = args.ws; F.ws = ws; F.out = args.out;
#pragma unroll
    for (int i = 0; i < 18; ++i) F.in[i] = args.in[i];
    F.ctl = (gu32*)(ws + WS_CTL);
    for (int u = F.tid; u < (LDS_BYTES - LDSCTL_OFF) / 4; u += NWAVES * 64) ((LAS unsigned*)(F.lds + LDSCTL_OFF))[u] = 0u;
    __syncthreads();
    XcdBarrier bar = xcd_barrier_post((unsigned*)(F.ctl + CW_BAR) + args.li * XCD_BAR_WORDS, F.MISC + 8);
    const int lo = args.ph_lo, hi = args.ph_hi;
#define IN(k) (lo <= (k) && (k) < hi)
#define SEAM(k) do { if (IN(k) && IN((k) + 1)) xcd_barrier(bar); } while (0)
    float* ss = (float*)(ws + WS_SS);
    bf16* XB = (bf16*)(ws + WS_XB); bf16* PROJ = (bf16*)(ws + WS_PROJ); bf16* HB = (bf16*)(ws + WS_H); bf16* OC = (bf16*)(ws + WS_OC); bf16* OB = (bf16*)(ws + WS_O);
    if (IN(0)) { p0_prologue(F); SEAM(0); }
#define LAYER_BODY(l) do { \
        const int pb = 1 + 7 * l; \
        if (IN(pb + 0)) { const int N = l ? NI1 : NI0; \
            pg8::Gemm g{XB, (const bf16*)(ws + (l ? WS_WIN1 : WS_WIN0)), M, N, D}; pg8::StaticOrder S; S.init(M, N, F.G, (int)blockIdx.x); \
            pg8::EpiProj E{PROJ, N, ss + (size_t)(2 * l) * M}; \
            pg8::gemm_phase<pg8::EpiProj, pg8::StaticOrder, PG8_ALIGN, PG8_SP2>(F.lds + RING_OFF, g, S, E); SEAM(pb + 0); } \
        if (IN(pb + 1)) { if (l == 0) rope_phase<0>(F); else rope_phase<1>(F); SEAM(pb + 1); } \
        if (IN(pb + 2)) { if (l == 0) attention_phase<0>(F, (char*)lds + RING_OFF); else attention_phase<1>(F, (char*)lds + RING_OFF); SEAM(pb + 2); } \
        if (IN(pb + 3)) { if (l == 1) { combine_phase(F); SEAM(pb + 3); } } \
        if (IN(pb + 4)) { pg8::Gemm g{l ? OC : OB, (const bf16*)(ws + (l ? WS_WO1 : WS_WO0)), M, D, D}; pg8::StaticOrder S; S.init(M, D, F.G, (int)blockIdx.x); \
            pg8::EpiResid E{l ? (const float*)F.out : F.in[0], F.out, XB, ss + (size_t)(2 * l + 1) * M}; \
            pg8::gemm_phase<pg8::EpiResid, pg8::StaticOrder, PG8_ALIGN, PG8_SP2>(F.lds + RING_OFF, g, S, E); SEAM(pb + 4); } \
        if (IN(pb + 5)) { pg8::Gemm g{XB, (const bf16*)(ws + (l ? WS_WGU1 : WS_WGU0)), M, 2 * FF, D}; pg8::StaticOrder S; S.init(M, 2 * FF, F.G, (int)blockIdx.x); \
            pg8::EpiSwiGLU E{HB, FF, ss + (size_t)(2 * l + 1) * M}; \
            pg8::gemm_phase<pg8::EpiSwiGLU, pg8::StaticOrder, PG8_ALIGN, PG8_SP2>(F.lds + RING_OFF, g, S, E); SEAM(pb + 5); } \
        if (IN(pb + 6)) { pg8::Gemm g{HB, (const bf16*)(ws + (l ? WS_WD1 : WS_WD0)), M, D, FF}; pg8::StaticOrder S; S.init(M, D, F.G, (int)blockIdx.x); \
            pg8::EpiResid E{F.out, F.out, XB, ss + (size_t)(2 * l + 2) * M}; \
            pg8::gemm_phase<pg8::EpiResid, pg8::StaticOrder, PG8_ALIGN, PG8_SP2>(F.lds + RING_OFF, g, S, E); SEAM(pb + 6); } \
    } while (0)
    LAYER_BODY(0);
    LAYER_BODY(1);
#undef LAYER_BODY
    if (IN(15)) final_norm_phase(F);
    if (IN(16)) cvt_rows(F, F.out, XB, ss + (size_t)args.cvt_ss * M);
#undef IN
#undef SEAM
}

static int g_grid = 0;
static int g_li = 0;
static void fast_seg(void* const* d_in, void* d_out, void* d_ws, hipStream_t stream, int lo, int hi, int cvt_ss = 0) {
    Args a{};
    for (int i = 0; i < 18; ++i) a.in[i] = (const float*)d_in[i];
    a.out = (float*)d_out; a.ws = (unsigned char*)d_ws; a.ph_lo = lo; a.ph_hi = hi; a.li = g_li++; a.cvt_ss = cvt_ss;
    hipLaunchKernelGGL(mk_fwd, dim3(g_grid), dim3(NWAVES * 64), LDS_BYTES, stream, a);
}
extern "C" void kernel_launch(void* const* d_in, const int* in_sizes, int n_in, void* d_out, int out_size, void* d_ws, size_t ws_size, hipStream_t stream) {
    if (g_grid == 0) {
        if (n_in != 18 || in_sizes[0] != M * D || out_size != M * D || ws_size < WS_END) { fprintf(stderr, "kernel_launch: unexpected shapes (n_in %d, ws %zu)\n", n_in, ws_size); g_grid = -1; return; }
        int dev = 0, cus = 0, per_cu = 0;
        if (hipGetDevice(&dev) != hipSuccess || hipDeviceGetAttribute(&cus, hipDeviceAttributeMultiprocessorCount, dev) != hipSuccess) { g_grid = -1; return; }
        if (hipFuncSetAttribute((const void*)mk_fwd, hipFuncAttributeMaxDynamicSharedMemorySize, LDS_BYTES) != hipSuccess) { fprintf(stderr, "kernel_launch: hipFuncSetAttribute failed\n"); g_grid = -1; return; }
        if (hipOccupancyMaxActiveBlocksPerMultiprocessor(&per_cu, (const void*)mk_fwd, NWAVES * 64, LDS_BYTES) != hipSuccess || per_cu < 1) fprintf(stderr, "kernel_launch: occupancy query reports %d\n", per_cu);
        (void)hipGetLastError();
        g_grid = cus;
    }
    if (g_grid < 0) return;
    g_li = 0;
    hipMemsetAsync((char*)d_ws + WS_CTL, 0, CTL_ZERO_BYTES, stream);
    fast_seg(d_in, d_out, d_ws, stream, 0, 16);

}
```

```cpp
#include <hip/hip_runtime.h>
#include <cstdio>
#include <cstdint>
namespace pg8 {
#define PG8_LAS __attribute__((address_space(3)))
typedef unsigned short bf16_t;
typedef short bf16x8 __attribute__((ext_vector_type(8)));
typedef float f32x4 __attribute__((ext_vector_type(4)));
typedef unsigned u32x4 __attribute__((ext_vector_type(4)));
constexpr int BM = 256, BK = 64, HALF = 128, HTB = HALF * BK * 2  , STAGE_BYTES = 8 * HTB, NXCD = 8, WGM = 8;

__host__ __device__ __forceinline__ int lds_byte(int r, int c) { const int st = (r >> 4) * 2 + (c >> 5), rr = r & 15, cc = c & 31, ob = rr * 64 + cc * 2; return st * 1024 + (ob ^ (((ob >> 9) & 1) << 5)); }
__host__ __device__ __forceinline__ void stage_rc(int b, int& R, int& C) { const int st = b / 1024, sb = b % 1024, swz = sb ^ (((sb >> 9) & 1) << 5); R = (st >> 1) * 16 + swz / 64; C = (st & 1) * 32 + (swz % 64) / 2; }
__host__ __device__ __forceinline__ int perm32(int rho) { const int n = rho >> 4, i = rho & 15; return 8 * (i >> 2) + 4 * n + (i & 3); }

struct Unit { int pm, pn; };
struct Gemm { const bf16_t* A; const bf16_t* Bt; int M, N, K; };

struct StaticOrder {
    int nM, nN, nwg, G, c;
    __host__ __device__ void init(int M, int N, int G_, int c_) { nM = M / BM; nN = N / BM; nwg = nM * nN; G = G_; c = c_; }
    __host__ __device__ bool next(int i, Unit& u) const {
        const long L = (long)i * G + c; if (L >= nwg) return false;
        int wgid = (int)L; { const int q = nwg / NXCD, r = nwg % NXCD, xcd = wgid % NXCD, off = wgid / NXCD; wgid = (xcd < r ? xcd * (q + 1) : r * (q + 1) + (xcd - r) * q) + off; }
        const int nig = WGM * nN, gid = wgid / nig, fm = gid * WGM, gsz = (nM - fm) < WGM ? (nM - fm) : WGM;
        u.pm = fm + ((wgid % nig) % gsz); u.pn = (wgid % nig) / gsz; return true;
    }
    __device__ __forceinline__ void a_ready(const Unit&) const {}
    __device__ __forceinline__ void done(const Unit&) const {}
};

__device__ __forceinline__ unsigned cvt_pk_bf16(float lo, float hi) { unsigned r; asm volatile("v_cvt_pk_bf16_f32 %0, %1, %2" : "=v"(r) : "v"(lo), "v"(hi)); return r; }
typedef float f32x2 __attribute__((ext_vector_type(2)));
constexpr float RMS_EPS = 1e-6f;
struct EpiProj {
    static constexpr bool PERM = true, AFTER_DRAIN = false;
    bf16_t* O; int ldc; const float* ss;
    __device__ __forceinline__ void operator()(const f32x4 (&acc)[2][2][4][2], const Unit& u, int wr, int wc, int fr, int fq) const {
        const int row0 = u.pm * BM + wr * 64 + fr, col0 = u.pn * BM + wc * 32 + 8 * fq;
#pragma unroll
        for (int ai = 0; ai < 2; ++ai)
#pragma unroll
            for (int m = 0; m < 4; ++m) { const int row = row0 + ai * HALF + m * 16; const float r = rsqrtf(ss[row] * (1.0f / 1024.0f) + RMS_EPS);
                bf16_t* rowp = O + (size_t)row * ldc + col0;
#pragma unroll
                for (int bj = 0; bj < 2; ++bj) { const f32x4 v0 = acc[ai][bj][m][0] * r, v1 = acc[ai][bj][m][1] * r; u32x4 w;
                    w.x = cvt_pk_bf16(v0[0], v0[1]); w.y = cvt_pk_bf16(v0[2], v0[3]); w.z = cvt_pk_bf16(v1[0], v1[1]); w.w = cvt_pk_bf16(v1[2], v1[3]);
                    *(u32x4*)(rowp + bj * HALF) = w; } }
    }
};
__device__ __forceinline__ float silu_mul(float g, float u) { return g * __builtin_amdgcn_rcpf(1.0f + __expf(-g)) * u; }
struct EpiSwiGLU {
    static constexpr bool PERM = true, AFTER_DRAIN = false;
    bf16_t* H; int ldc; const float* ss;
    __device__ __forceinline__ void operator()(const f32x4 (&acc)[2][2][4][2], const Unit& u, int wr, int wc, int fr, int fq) const {
        const int row0 = u.pm * BM + wr * 64 + fr, col0 = u.pn * HALF + wc * 32 + 8 * fq;
#pragma unroll
        for (int ai = 0; ai < 2; ++ai)
#pragma unroll
            for (int m = 0; m < 4; ++m) { const int row = row0 + ai * HALF + m * 16; const float r = rsqrtf(ss[row] * (1.0f / 1024.0f) + RMS_EPS);
                const f32x4 g0 = acc[ai][0][m][0] * r, g1 = acc[ai][0][m][1] * r, u0 = acc[ai][1][m][0] * r, u1 = acc[ai][1][m][1] * r; u32x4 w;
                w.x = cvt_pk_bf16(silu_mul(g0[0], u0[0]), silu_mul(g0[1], u0[1])); w.y = cvt_pk_bf16(silu_mul(g0[2], u0[2]), silu_mul(g0[3], u0[3]));
                w.z = cvt_pk_bf16(silu_mul(g1[0], u1[0]), silu_mul(g1[1], u1[1])); w.w = cvt_pk_bf16(silu_mul(g1[2], u1[2]), silu_mul(g1[3], u1[3]));
                *(u32x4*)(H + (size_t)row * ldc + col0) = w; }
    }
};
struct EpiResid {
    static constexpr bool PERM = true, AFTER_DRAIN = false;
    const float* base; float* out; bf16_t* xb; float* ssn;
    __device__ __forceinline__ void operator()(const f32x4 (&acc)[2][2][4][2], const Unit& u, int wr, int wc, int fr, int fq) const {
        const int row0 = u.pm * BM + wr * 64 + fr, col0 = u.pn * BM + wc * 32 + 8 * fq;
#pragma unroll
        for (int ai = 0; ai < 2; ++ai)
#pragma unroll
            for (int m = 0; m < 4; ++m) { const int row = row0 + ai * HALF + m * 16; const size_t off = (size_t)row * 1024 + col0; float q = 0.f;
#pragma unroll
                for (int bj = 0; bj < 2; ++bj) { const f32x4 b0 = *(const f32x4*)(base + off + bj * HALF), b1 = *(const f32x4*)(base + off + bj * HALF + 4);
                    const f32x4 x0 = b0 + acc[ai][bj][m][0], x1 = b1 + acc[ai][bj][m][1];
                    *(f32x4*)(out + off + bj * HALF) = x0; *(f32x4*)(out + off + bj * HALF + 4) = x1;
                    q += (x0[0] * x0[0] + x0[1] * x0[1]) + (x0[2] * x0[2] + x0[3] * x0[3]) + (x1[0] * x1[0] + x1[1] * x1[1]) + (x1[2] * x1[2] + x1[3] * x1[3]);
                    u32x4 w; w.x = cvt_pk_bf16(x0[0], x0[1]); w.y = cvt_pk_bf16(x0[2], x0[3]); w.z = cvt_pk_bf16(x1[0], x1[1]); w.w = cvt_pk_bf16(x1[2], x1[3]);
                    *(u32x4*)(xb + off + bj * HALF) = w; }
                q += __shfl_xor(q, 16); q += __shfl_xor(q, 32);
                if (fq == 0) __hip_atomic_fetch_add(ssn + row, q, __ATOMIC_RELAXED, __HIP_MEMORY_SCOPE_AGENT);
                asm volatile("" ::: "memory"); }
    }
};

template <class Epi, class Sched, bool ALIGN_EPI = false, bool SP2 = false>
__device__ __forceinline__ void gemm_phase(PG8_LAS unsigned char* lds, const Gemm g, const Sched& S, const Epi& E) {
    const int tid = threadIdx.x, wid = __builtin_amdgcn_readfirstlane(tid >> 6), lane = tid & 63, wr = wid >> 2, wc = wid & 3, fr = lane & 15, fq = lane >> 4;
    const int K = g.K, nt = K / BK;
    unsigned voffA[2], voffB[2];
#pragma unroll
    for (int i = 0; i < 2; ++i) { int R, C; stage_rc(tid * 16 + i * 8192, R, C); const int Rb = Epi::PERM ? ((R & ~31) + perm32(R & 31)) : R;
        voffA[i] = (unsigned)(R * K + C) * 2u; voffB[i] = (unsigned)(Rb * K + C) * 2u; }
    const size_t kstep = (size_t)(BK * 2);
    const size_t hstep = (size_t)HALF * K * 2;
    const size_t tstep = 2 * hstep;
    const unsigned ldsw = (unsigned)wid * 1024u;
    const int aoff = lds_byte(wr * 64 + fr, fq * 8), boff = lds_byte(wc * 32 + fr, fq * 8);
#define PG8_SA(b, h) (((b) * 2 + (h)) * HTB)
#define PG8_SB(b, h) ((4 + (b) * 2 + (h)) * HTB)
#define PG8_STAGE(bufoff, gbase, voff) do { _Pragma("unroll") for (int _i = 0; _i < 2; ++_i) \
        __builtin_amdgcn_global_load_lds((const unsigned*)((const char*)(gbase) + (voff)[_i]), (PG8_LAS unsigned*)(lds + (bufoff) + ldsw + _i * 8192), 16, 0, 0); } while (0)
#define PG8_LDA(dst, b, h) do { _Pragma("unroll") for (int m = 0; m < 4; ++m) _Pragma("unroll") for (int k = 0; k < 2; ++k) dst[m][k] = *(const PG8_LAS bf16x8*)(lds + PG8_SA(b, h) + aoff + m * 2048 + k * 1024); } while (0)
#define PG8_LDB(dst, b, h) do { _Pragma("unroll") for (int n = 0; n < 2; ++n) _Pragma("unroll") for (int k = 0; k < 2; ++k) dst[n][k] = *(const PG8_LAS bf16x8*)(lds + PG8_SB(b, h) + boff + n * 2048 + k * 1024); } while (0)
#define PG8_MMA(ai, bj, At, Bt) do { __builtin_amdgcn_s_setprio(1); _Pragma("unroll") for (int m = 0; m < 4; ++m) _Pragma("unroll") for (int n = 0; n < 2; ++n) _Pragma("unroll") for (int k = 0; k < 2; ++k) \
        acc[ai][bj][m][n] = __builtin_amdgcn_mfma_f32_16x16x32_bf16(Bt[n][k], At[m][k], acc[ai][bj][m][n], 0, 0, 0); __builtin_amdgcn_s_setprio(0); } while (0)
#define PG8_WAIT_V(n) asm volatile("s_waitcnt vmcnt(" #n ")" ::: "memory")
#define PG8_WAIT_L(n) asm volatile("s_waitcnt lgkmcnt(" #n ")" ::: "memory")
#define PG8_BAR __builtin_amdgcn_s_barrier()
#define PG8_SCHED __builtin_amdgcn_sched_barrier(0)
    Unit cur, nxt; int ui = 0;
    if (!S.next(0, cur)) return;
    f32x4 acc[2][2][4][2];
#pragma unroll
    for (int a = 0; a < 2; ++a)
#pragma unroll
        for (int b = 0; b < 2; ++b)
#pragma unroll
            for (int m = 0; m < 4; ++m)
#pragma unroll
                for (int n = 0; n < 2; ++n) acc[a][b][m][n] = (f32x4){0.f, 0.f, 0.f, 0.f};
    bf16x8 At[4][2], B0[2][2], B1[2][2];
    const char* cA = (const char*)g.A + (size_t)cur.pm * tstep; const char* cB = (const char*)g.Bt + (size_t)cur.pn * tstep;
    S.a_ready(cur);
    if constexpr (SP2) {
        PG8_STAGE(PG8_SB(0, 0), cB, voffB); PG8_STAGE(PG8_SB(0, 1), cB + hstep, voffB); PG8_STAGE(PG8_SA(0, 0), cA, voffA); PG8_STAGE(PG8_SA(0, 1), cA + hstep, voffA);
        if (wr == 1) PG8_BAR;
        PG8_WAIT_V(2); PG8_BAR;
        PG8_STAGE(PG8_SB(1, 0), cB + kstep, voffB); PG8_STAGE(PG8_SA(1, 0), cA + kstep, voffA); PG8_STAGE(PG8_SB(1, 1), cB + hstep + kstep, voffB);
        PG8_WAIT_V(6); PG8_BAR;
    } else {
        PG8_STAGE(PG8_SB(0, 0), cB, voffB); PG8_STAGE(PG8_SA(0, 0), cA, voffA); PG8_STAGE(PG8_SB(0, 1), cB + hstep, voffB); PG8_STAGE(PG8_SA(0, 1), cA + hstep, voffA);
        if (wr == 1) PG8_BAR;
        PG8_WAIT_V(4); PG8_BAR;
        PG8_STAGE(PG8_SB(1, 0), cB + kstep, voffB); PG8_STAGE(PG8_SA(1, 0), cA + kstep, voffA); PG8_STAGE(PG8_SB(1, 1), cB + hstep + kstep, voffB);
        PG8_WAIT_V(6); PG8_BAR;
    }
    for (;;) {
        const bool has_next = S.next(ui + 1, nxt);
        const char* nA = has_next ? (const char*)g.A + (size_t)nxt.pm * tstep : cA; const char* nB = has_next ? (const char*)g.Bt + (size_t)nxt.pn * tstep : cB;
        for (int t = 0; t < nt; t += 2) {
            const bool last = (t == nt - 2);
            const char* a1 = cA + (size_t)(t + 1) * kstep;
            const char* a2 = last ? nA : cA + (size_t)(t + 2) * kstep; const char* b2 = last ? nB : cB + (size_t)(t + 2) * kstep;
            const char* a3 = a2 + kstep; const char* b3 = b2 + kstep;
            if (last && has_next) S.a_ready(nxt);
            if constexpr (SP2) {
            PG8_LDB(B0, 0, 0); PG8_LDB(B1, 0, 1); PG8_SCHED; PG8_LDA(At, 0, 0); PG8_STAGE(PG8_SA(1, 1), a1 + hstep, voffA);
            PG8_WAIT_V(8); PG8_WAIT_L(0); PG8_BAR; PG8_MMA(0, 0, At, B0); PG8_MMA(0, 1, At, B1); PG8_BAR; PG8_SCHED;
            PG8_LDA(At, 0, 1); PG8_STAGE(PG8_SB(0, 0), b2, voffB); PG8_STAGE(PG8_SB(0, 1), b2 + hstep, voffB); PG8_STAGE(PG8_SA(0, 0), a2, voffA);
            PG8_WAIT_V(8); PG8_WAIT_L(0); PG8_BAR; PG8_MMA(1, 0, At, B0); PG8_MMA(1, 1, At, B1); PG8_BAR; PG8_SCHED;
            PG8_LDB(B0, 1, 0); PG8_LDB(B1, 1, 1); PG8_SCHED; PG8_LDA(At, 1, 0); PG8_STAGE(PG8_SA(0, 1), a2 + hstep, voffA);
            PG8_WAIT_V(8); PG8_WAIT_L(0); PG8_BAR; PG8_MMA(0, 0, At, B0); PG8_MMA(0, 1, At, B1); PG8_BAR; PG8_SCHED;
            PG8_LDA(At, 1, 1); PG8_STAGE(PG8_SB(1, 0), b3, voffB); PG8_STAGE(PG8_SB(1, 1), b3 + hstep, voffB); PG8_STAGE(PG8_SA(1, 0), a3, voffA);
            PG8_WAIT_V(8); PG8_WAIT_L(0); PG8_BAR; PG8_MMA(1, 0, At, B0); PG8_MMA(1, 1, At, B1); PG8_BAR; PG8_SCHED;
            } else {
            PG8_LDB(B0, 0, 0); PG8_SCHED; PG8_LDA(At, 0, 0); PG8_STAGE(PG8_SA(1, 1), a1 + hstep, voffA);
            PG8_WAIT_L(8); PG8_BAR; PG8_WAIT_L(0); PG8_MMA(0, 0, At, B0); PG8_BAR; PG8_SCHED;
            PG8_LDB(B1, 0, 1); PG8_STAGE(PG8_SB(0, 0), b2, voffB);
            PG8_BAR; PG8_WAIT_L(0); PG8_MMA(0, 1, At, B1); PG8_BAR;
            PG8_LDA(At, 0, 1); PG8_STAGE(PG8_SA(0, 0), a2, voffA);
            PG8_BAR; PG8_WAIT_L(0); PG8_MMA(1, 0, At, B0); PG8_BAR; PG8_SCHED;
            PG8_STAGE(PG8_SB(0, 1), b2 + hstep, voffB);
            PG8_WAIT_V(6); PG8_BAR; PG8_MMA(1, 1, At, B1); PG8_BAR;
            PG8_LDB(B0, 1, 0); PG8_SCHED; PG8_LDA(At, 1, 0); PG8_STAGE(PG8_SA(0, 1), a2 + hstep, voffA);
            PG8_WAIT_L(8); PG8_BAR; PG8_WAIT_L(0); PG8_MMA(0, 0, At, B0); PG8_BAR; PG8_SCHED;
            PG8_LDB(B1, 1, 1); PG8_STAGE(PG8_SB(1, 0), b3, voffB);
            PG8_BAR; PG8_WAIT_L(0); PG8_MMA(0, 1, At, B1); PG8_BAR;
            PG8_LDA(At, 1, 1); PG8_STAGE(PG8_SA(1, 0), a3, voffA);
            PG8_BAR; PG8_WAIT_L(0); PG8_MMA(1, 0, At, B0); PG8_BAR; PG8_SCHED;
            PG8_STAGE(PG8_SB(1, 1), b3 + hstep, voffB);
            PG8_WAIT_V(6); PG8_BAR; PG8_MMA(1, 1, At, B1); PG8_BAR;
            }
        }
        if constexpr (ALIGN_EPI) { if (wr == 0) PG8_BAR; }
        if constexpr (!Epi::AFTER_DRAIN) { E(acc, cur, wr, wc, fr, fq); S.done(cur); }
        if (!has_next) break;
#pragma unroll
        for (int a = 0; a < 2; ++a)
#pragma unroll
            for (int b = 0; b < 2; ++b)
#pragma unroll
                for (int m = 0; m < 4; ++m)
#pragma unroll
                    for (int n = 0; n < 2; ++n) acc[a][b][m][n] = (f32x4){0.f, 0.f, 0.f, 0.f};
        cur = nxt; cA = nA; cB = nB; ++ui;
        if constexpr (ALIGN_EPI) { if (wr == 1) PG8_BAR; }
    }
    PG8_WAIT_V(0);
    if constexpr (!ALIGN_EPI) { if (wr == 0) PG8_BAR; }
    PG8_BAR;
    if constexpr (Epi::AFTER_DRAIN) { E.fused(acc, cur, wr, wc, fr, fq, lds, wid, lane); S.done(cur); }
#undef PG8_SA
#undef PG8_SB
#undef PG8_STAGE
#undef PG8_LDA
#undef PG8_LDB
#undef PG8_MMA
#undef PG8_WAIT_V
#undef PG8_WAIT_L
#undef PG8_BAR
#undef PG8_SCHED
}
}

#ifndef PG8_SP2
#define PG8_SP2 true
#endif
#ifndef PG8_ALIGN
#define PG8_ALIGN true
#endif
#include <hip/hip_bf16.h>
#include <cmath>
namespace attn_body {
using bf16=__hip_bfloat16;
using bf16x8=__attribute__((ext_vector_type(8)))short;
using s16x4=__attribute__((ext_vector_type(4)))short;
using f32x16=__attribute__((ext_vector_type(16)))float;
using u32x4=__attribute__((ext_vector_type(4)))unsigned;
constexpr int SEQ=8192,D=64;
constexpr int NW=8,QBLK=32,QB=QBLK*NW,KVBLK=64,NQB=SEQ/QB;
constexpr int ATTN_UNIT_ROWS=QB;
__device__ __forceinline__ int crow(int r,int hi){return (r&3)+8*(r>>2)+4*hi;}
#define SBAR() __builtin_amdgcn_sched_barrier(0)
__device__ __forceinline__ void cmask(f32x16&p0,f32x16&p1,int jb,int qrel,int hi){
  const float NEG=-INFINITY; int kb=64*jb+4*hi;
  #pragma unroll
  for(int r=0;r<16;++r){int kv=kb+(r&3)+8*(r>>2); if(kv>qrel)p0[r]=NEG; if(kv+32>qrel)p1[r]=NEG;}
}

typedef __attribute__((address_space(3))) const float* lds_fptr;
__device__ __forceinline__ void dmask(f32x16&p0,f32x16&p1,lds_fptr tb){
  #pragma unroll
  for(int r=0;r<16;++r){p0[r]+=tb[(r&3)+8*(r>>2)]; p1[r]+=tb[32+(r&3)+8*(r>>2)];}
}
constexpr int NSLOT=3, SLOTB=8192;
constexpr int LDS_K=0, LDS_V=NSLOT*SLOTB, LDS_WS=2*NSLOT*SLOTB, LDS_OST=LDS_WS+NW*64*4, LDS_BYTES=LDS_OST+NW*4096;
constexpr float C2=0.125f*1.4426950408889634f;
__device__ __forceinline__ void glds16(const void*gsrc,unsigned lds_dst){unsigned keep;
  asm volatile("s_mov_b32 %0, m0\n\ts_mov_b32 m0, %2\n\ts_nop 0\n\tglobal_load_lds_dwordx4 %1, off\n\ts_mov_b32 m0, %0":"=&s"(keep):"v"(gsrc),"s"(lds_dst):"memory");}
__device__ __forceinline__ float max3f(float a,float b,float c){float r;asm("v_max3_f32 %0, %1, %2, %3":"=v"(r):"v"(a),"v"(b),"v"(c));return r;}
__device__ __forceinline__ float max2f(float a,float b){float r;asm("v_max_f32_e32 %0, %1, %2":"=v"(r):"v"(a),"v"(b));return r;}
__device__ __forceinline__ float fadd_s(float a,float b){float r;asm("v_add_f32_e32 %0, %1, %2":"=v"(r):"v"(a),"v"(b));return r;}
__device__ __forceinline__ float fsub_s(float a,float b){float r;asm("v_sub_f32_e32 %0, %1, %2":"=v"(r):"v"(a),"v"(b));return r;}
typedef float f32x2_t __attribute__((ext_vector_type(2))); typedef __bf16 bf16x2_t __attribute__((ext_vector_type(2)));
__device__ __forceinline__ unsigned cvtpk_s(float lo,float hi){f32x2_t v={lo,hi};bf16x2_t b=__builtin_convertvector(v,bf16x2_t);return __builtin_bit_cast(unsigned,b);}
#define WAIT_BAR(N) asm volatile("s_waitcnt vmcnt(" #N ") lgkmcnt(0)\n\ts_barrier":::"memory")

__device__ __forceinline__ void qkt(f32x16&p0,f32x16&p1,const char*Kslot,const bf16x8*qr,const f32x16&negm,int r32,int hi){
  const char*kb=Kslot+hi*1024+r32*16;
  #pragma unroll
  for(int d0=0;d0<4;++d0){
    const bf16x8 b0=*reinterpret_cast<const bf16x8*>(kb+d0*2048);
    const bf16x8 b1=*reinterpret_cast<const bf16x8*>(kb+d0*2048+512);
    if(d0==0){p0=__builtin_amdgcn_mfma_f32_32x32x16_bf16(b0,qr[0],negm,0,0,0);p1=__builtin_amdgcn_mfma_f32_32x32x16_bf16(b1,qr[0],negm,0,0,0);}
    else{p0=__builtin_amdgcn_mfma_f32_32x32x16_bf16(b0,qr[d0],p0,0,0,0);p1=__builtin_amdgcn_mfma_f32_32x32x16_bf16(b1,qr[d0],p1,0,0,0);}}
}
typedef __attribute__((address_space(3))) const char* lds_cptr;
typedef short v4i16_t __attribute__((ext_vector_type(4)));
__device__ __forceinline__ void kload8(bf16x8*kf,lds_cptr kp){
  kf[0]=*(const __attribute__((address_space(3))) bf16x8*)(kp);      kf[1]=*(const __attribute__((address_space(3))) bf16x8*)(kp+512);
  kf[2]=*(const __attribute__((address_space(3))) bf16x8*)(kp+2048); kf[3]=*(const __attribute__((address_space(3))) bf16x8*)(kp+2560);
  kf[4]=*(const __attribute__((address_space(3))) bf16x8*)(kp+4096); kf[5]=*(const __attribute__((address_space(3))) bf16x8*)(kp+4608);
  kf[6]=*(const __attribute__((address_space(3))) bf16x8*)(kp+6144); kf[7]=*(const __attribute__((address_space(3))) bf16x8*)(kp+6656);
}
__device__ __forceinline__ void kload2(bf16x8*kf,lds_cptr kp,int j){ kf[2*j]=*(const __attribute__((address_space(3))) bf16x8*)(kp+j*2048); kf[2*j+1]=*(const __attribute__((address_space(3))) bf16x8*)(kp+j*2048+512); }
__device__ __forceinline__ s16x4 vtr(lds_cptr p){ return __builtin_bit_cast(s16x4,__builtin_amdgcn_ds_read_tr16_b64_v4i16((__attribute__((address_space(3))) v4i16_t*)p)); }
__device__ __forceinline__ float rowmax(const f32x16&p0,const f32x16&p1){
  float a=max3f(p0[0],p0[1],p1[0]),b=max3f(p0[2],p0[3],p1[1]);a=max3f(a,p1[2],p1[3]);
  #pragma unroll
  for(int r=4;r<16;r+=4){a=max3f(a,p0[r],p0[r+1]);b=max3f(b,p0[r+2],p0[r+3]);a=max3f(a,p1[r],p1[r+1]);b=max3f(b,p1[r+2],p1[r+3]);}
  const float m=max2f(a,b);
  auto rr=__builtin_amdgcn_permlane32_swap(__float_as_uint(m),__float_as_uint(m),false,false);
  return max2f(__uint_as_float(rr[0]),__uint_as_float(rr[1]));
}
__device__ __forceinline__ void pv(f32x16*o,int vb,bf16x8 pa0,bf16x8 pa1,bf16x8 pa2,bf16x8 pa3){
  #pragma unroll
  for(int d0=0;d0<2;++d0){s16x4 lo[4],hi[4];
    #pragma unroll
    for(int ks=0;ks<4;++ks){
      asm volatile("ds_read_b64_tr_b16 %0,%1 offset:%c2":"=&v"(lo[ks]):"v"(vb),"i"(d0*4096+ks*1024):"memory");
      asm volatile("ds_read_b64_tr_b16 %0,%1 offset:%c2":"=&v"(hi[ks]):"v"(vb),"i"(d0*4096+ks*1024+512):"memory");}
    asm volatile("s_waitcnt lgkmcnt(0)":::"memory");SBAR();
    #define PK(k) (bf16x8){lo[k][0],lo[k][1],lo[k][2],lo[k][3],hi[k][0],hi[k][1],hi[k][2],hi[k][3]}
    o[d0]=__builtin_amdgcn_mfma_f32_32x32x16_bf16(pa0,PK(0),o[d0],0,0,0);
    o[d0]=__builtin_amdgcn_mfma_f32_32x32x16_bf16(pa1,PK(1),o[d0],0,0,0);
    o[d0]=__builtin_amdgcn_mfma_f32_32x32x16_bf16(pa2,PK(2),o[d0],0,0,0);
    o[d0]=__builtin_amdgcn_mfma_f32_32x32x16_bf16(pa3,PK(3),o[d0],0,0,0);
    #undef PK
  }
}

#ifndef ATTN_STORE16
#define ATTN_STORE16(p,v) (*(u32x4*)(p)=(v))
#endif
constexpr int DTBL_OFF=86016, DTBL_N=2560;
template<int THRL,int MODE> __device__ __forceinline__ void attn_unit(const bf16*Qb,const bf16*__restrict__ Kt0,const bf16*__restrict__ Vt0,bf16*Ob,const int pin,const int pout,const int NT,const int kvbase,char*shm){
  const int tid=threadIdx.x,lane=tid&63,r32=lane&31,hi=lane>>5; const int wid=__builtin_amdgcn_readfirstlane(tid>>6);
  const bf16*Qw=Qb+(long)(wid*QBLK)*pin;
  const bf16*Kh=Kt0,*Vh=Vt0;
  const unsigned lds0=(unsigned)(uintptr_t)shm;
  float*wsf=(float*)(shm+LDS_WS)+wid*64;
  const bf16*ksrc=Kh+(long)lane*pin+wid*8;
  const bf16*vsrc=Vh+(long)(16*(wid&3)+(lane>>2))*pin+(wid>>2)*32+(lane&3)*8;
  const unsigned kdst=lds0+LDS_K+wid*1024, vdst=lds0+LDS_V+wid*1024;
  #define DMA_K(t,slot) glds16(ksrc+(long)(t)*KVBLK*pin,(unsigned)__builtin_amdgcn_readfirstlane(kdst+(slot)))
  #define DMA_V(t,slot) glds16(vsrc+(long)(t)*KVBLK*pin,(unsigned)__builtin_amdgcn_readfirstlane(vdst+(slot)))
  const int vb0=(int)(lds0+LDS_V)+((lane>>4)&1)*32+(lane&3)*8+(4*hi+((lane&15)>>2))*64;
  const char*Kbase=shm+LDS_K; bf16x8 kf[8];
  const lds_cptr shm3=(lds_cptr)shm; const lds_cptr kp0=shm3+LDS_K+hi*1024+r32*16; const lds_cptr vp0=shm3+LDS_V+((lane>>4)&1)*32+(lane&3)*8+(4*hi+((lane&15)>>2))*64;
  DMA_K(0,0);DMA_V(0,0);DMA_K(1,SLOTB);
  bf16x8 qr[4];
  #pragma unroll
  for(int d0=0;d0<4;++d0)qr[d0]=*reinterpret_cast<const bf16x8*>(&Qw[(long)r32*pin+d0*16+hi*8]);
  float mhat=0.f,l_reg=0.f;f32x16 o[2];o[0]=f32x16{};o[1]=f32x16{};f32x16 negm=f32x16{};asm volatile("":"+v"(negm));
  const int qrel=wid*QBLK+r32;
  const lds_fptr dtb=(lds_fptr)(shm3+DTBL_OFF)+(kvbase+4*hi-qrel+1280);
  #define CMASK(P0,P1,t) do{ if(MODE==1) dmask(P0,P1,dtb+64*(t)); }while(0)
  bool resc=false;
  #define START(P0,P1) do{ const float rm=rowmax(P0,P1); resc=false; \
    { const float dl=rm; mhat=fadd_s(mhat,dl); \
      _Pragma("unroll") for(int r=0;r<16;++r){P0[r]=fsub_s(P0[r],dl);P1[r]=fsub_s(P1[r],dl);} \
      _Pragma("unroll") for(int r=0;r<16;++r)negm[r]=-mhat; asm volatile("":"+v"(negm)); } \
    _Pragma("unroll") for(int r=0;r<16;++r)P0[r]=__builtin_amdgcn_exp2f(P0[r]); }while(0)
  #define RESC() do{ if(resc){ asm volatile("s_waitcnt lgkmcnt(0)":::"memory"); \
      _Pragma("unroll") for(int d_=0;d_<2;++d_) _Pragma("unroll") for(int r=0;r<16;++r)o[d_][r]*=wsf[crow(r,hi)]; } }while(0)
  f32x16 pA0,pA1,pB0,pB1;
  int sl_prev=0,sl_cur=0,sl_next=SLOTB;
  #define ROT() do{sl_prev=sl_cur;sl_cur=sl_next;sl_next=(sl_next==(NSLOT-1)*SLOTB)?0:sl_next+SLOTB;}while(0)
  DMA_K(2,2*SLOTB);
  WAIT_BAR(3);
  qkt(pA0,pA1,Kbase,qr,negm,r32,hi);asm volatile("s_nop 15\n\ts_nop 7":"+v"(pA0),"+v"(pA1));CMASK(pA0,pA1,0);
  START(pA0,pA1);
  _Pragma("unroll") for(int r=0;r<16;++r)pA1[r]=__builtin_amdgcn_exp2f(pA1[r]);
  WAIT_BAR(0);
  DMA_K(3,0);DMA_V(1,SLOTB);
  ROT();
  kload8(kf,kp0+sl_cur);
  WAIT_BAR(2);
  s16x4 vlo[8],vhi[8]; u32x4 pw0,pw1,pw2,pw3;
  #define PKW(P,B) cvtpk_s(P[B],P[B+1])
  #define PAF(k) __builtin_bit_cast(bf16x8,pw##k)
  #define VFR(i) (bf16x8){vlo[i][0],vlo[i][1],vlo[i][2],vlo[i][3],vhi[i][0],vhi[i][1],vhi[i][2],vhi[i][3]}
  #define PIN(x) asm volatile("":"+v"(x))
  #define MX3(a,b,c) __builtin_fmaxf(__builtin_fmaxf((a),(b)),(c))
  #define GAPA(MF,A0,A1,A2,A3,W0,W1,PW) do{ MF; sacc+=A0; sacc+=A1; sacc+=A2; sacc+=A3; PIN(sacc); W0; W1; PIN(PW); SBAR(); }while(0)
  #define EX(v) __builtin_amdgcn_exp2f(v)
  #define GAPB(MF,X,B) do{ MF; X[B]=EX(X[B]); X[B+1]=EX(X[B+1]); X[B+2]=EX(X[B+2]); X[B+3]=EX(X[B+3]); PIN(X); SBAR(); }while(0)
  #define VRD(i) do{ vlo[i]=vtr(vp_+(((i)>>2)*4096+((i)&3)*1024)); vhi[i]=vtr(vp_+(((i)>>2)*4096+((i)&3)*1024+512)); }while(0)
  #define KRD(G,j) do{ if(G){ kload2(kf,kp0+sl_next,j); SBAR(); } }while(0)
  #define STEP(C0,C1,P0,P1,t,GK,GV,GL) do{ SBAR(); \
    const lds_cptr vp_=vp0+sl_prev; \
    VRD(0); SBAR(); float sacc=(P0[0]+P0[1]); \
    GAPA(C0=__builtin_amdgcn_mfma_f32_32x32x16_bf16(kf[0],qr[0],negm,0,0,0), P0[2],P0[3],P0[4],P0[5],     pw0[0]=PKW(P0,0), pw0[1]=PKW(P0,2), pw0); \
    VRD(4); SBAR(); GAPA(C1=__builtin_amdgcn_mfma_f32_32x32x16_bf16(kf[1],qr[0],negm,0,0,0), P0[6],P0[7],P0[8],P0[9],     pw0[2]=PKW(P0,4), pw0[3]=PKW(P0,6), pw0); \
    VRD(1); SBAR(); GAPA(C0=__builtin_amdgcn_mfma_f32_32x32x16_bf16(kf[2],qr[1],C0,0,0,0),   P0[10],P0[11],P0[12],P0[13], pw1[0]=PKW(P0,8), pw1[1]=PKW(P0,10), pw1); \
    VRD(5); SBAR(); GAPA(C1=__builtin_amdgcn_mfma_f32_32x32x16_bf16(kf[3],qr[1],C1,0,0,0),   P0[14],P0[15],P1[0],P1[1],   pw1[2]=PKW(P0,12),pw1[3]=PKW(P0,14), pw1); \
    VRD(2); SBAR(); GAPA(C0=__builtin_amdgcn_mfma_f32_32x32x16_bf16(kf[4],qr[2],C0,0,0,0),   P1[2],P1[3],P1[4],P1[5],     pw2[0]=PKW(P1,0), pw2[1]=PKW(P1,2), pw2); \
    VRD(6); SBAR(); GAPA(C1=__builtin_amdgcn_mfma_f32_32x32x16_bf16(kf[5],qr[2],C1,0,0,0),   P1[6],P1[7],P1[8],P1[9],     pw2[2]=PKW(P1,4), pw2[3]=PKW(P1,6), pw2); \
    VRD(3); SBAR(); GAPA(C0=__builtin_amdgcn_mfma_f32_32x32x16_bf16(kf[6],qr[3],C0,0,0,0),   P1[10],P1[11],P1[12],P1[13], pw3[0]=PKW(P1,8), pw3[1]=PKW(P1,10), pw3); \
    VRD(7); SBAR(); GAPA(C1=__builtin_amdgcn_mfma_f32_32x32x16_bf16(kf[7],qr[3],C1,0,0,0),   P1[14],P1[15],0.f,0.f,       pw3[2]=PKW(P1,12),pw3[3]=PKW(P1,14), pw3); \
    l_reg+=sacc; \
    if(GK){DMA_K((t)+3,sl_cur);} if(GV){DMA_V((t)+1,sl_next);} \
    CMASK(C0,C1,t); \
    { float a=MX3(C0[0],C0[1],C1[0]),b=MX3(C0[2],C0[3],C1[1]); a=MX3(a,C1[2],C1[3]); \
      _Pragma("unroll") for(int r=4;r<16;r+=4){a=MX3(a,C0[r],C0[r+1]);b=MX3(b,C0[r+2],C0[r+3]);a=MX3(a,C1[r],C1[r+1]);b=MX3(b,C1[r+2],C1[r+3]);} \
      float rm=__builtin_fmaxf(a,b); { auto rr=__builtin_amdgcn_permlane32_swap(__float_as_uint(rm),__float_as_uint(rm),false,false); rm=__builtin_fmaxf(__uint_as_float(rr[0]),__uint_as_float(rr[1])); } \
      resc=false; \
      if(__builtin_expect(__any(rm>(float)THRL),0)){ const float dl=__builtin_fmaxf(rm,0.f); mhat+=dl; \
        _Pragma("unroll") for(int r=0;r<16;++r){C0[r]-=dl;C1[r]-=dl;} \
        _Pragma("unroll") for(int r=0;r<16;++r)negm[r]=-mhat; asm volatile("":"+v"(negm)); \
        const float f=__builtin_amdgcn_exp2f(-dl); l_reg*=f; if(hi==0)wsf[r32]=f; resc=true; } } \
    SBAR(); \
    GAPB(o[0]=__builtin_amdgcn_mfma_f32_32x32x16_bf16(PAF(0),VFR(0),o[0],0,0,0), C0,0); \
    GAPB(o[1]=__builtin_amdgcn_mfma_f32_32x32x16_bf16(PAF(0),VFR(4),o[1],0,0,0), C0,4); \
    KRD(GL,0); GAPB(o[0]=__builtin_amdgcn_mfma_f32_32x32x16_bf16(PAF(1),VFR(1),o[0],0,0,0), C0,8); \
    KRD(GL,1); GAPB(o[1]=__builtin_amdgcn_mfma_f32_32x32x16_bf16(PAF(1),VFR(5),o[1],0,0,0), C0,12); \
    KRD(GL,2); GAPB(o[0]=__builtin_amdgcn_mfma_f32_32x32x16_bf16(PAF(2),VFR(2),o[0],0,0,0), C1,0); \
    KRD(GL,3); GAPB(o[1]=__builtin_amdgcn_mfma_f32_32x32x16_bf16(PAF(2),VFR(6),o[1],0,0,0), C1,4); \
    GAPB(o[0]=__builtin_amdgcn_mfma_f32_32x32x16_bf16(PAF(3),VFR(3),o[0],0,0,0), C1,8); \
    GAPB(o[1]=__builtin_amdgcn_mfma_f32_32x32x16_bf16(PAF(3),VFR(7),o[1],0,0,0), C1,12); \
    }while(0)
  int t=1;
  for(;t+5<NT;t+=2){
    STEP(pB0,pB1,pA0,pA1,t,true,true,true);     WAIT_BAR(2); RESC(); ROT();
    STEP(pA0,pA1,pB0,pB1,t+1,true,true,true);   WAIT_BAR(2); RESC(); ROT();
  }
  #define ENDW(tt) do{ if((tt)+3<NT){WAIT_BAR(2);} else if((tt)+2<NT){WAIT_BAR(1);} else {WAIT_BAR(0);} }while(0)
  for(;t+1<NT;t+=2){
    STEP(pB0,pB1,pA0,pA1,t,(t+3<NT),(t+1<NT),(t+1<NT));       ENDW(t);   RESC(); ROT();
    STEP(pA0,pA1,pB0,pB1,t+1,(t+4<NT),(t+2<NT),(t+2<NT));     ENDW(t+1); RESC(); ROT();
  }
  STEP(pB0,pB1,pA0,pA1,NT-1,false,false,false); RESC();
  { float sacc=pB0[0]+pB0[1]; _Pragma("unroll") for(int r=2;r<16;++r)sacc+=pB0[r]; _Pragma("unroll") for(int r=0;r<16;++r)sacc+=pB1[r]; l_reg+=sacc;
    pw0=(u32x4){PKW(pB0,0),PKW(pB0,2),PKW(pB0,4),PKW(pB0,6)};pw1=(u32x4){PKW(pB0,8),PKW(pB0,10),PKW(pB0,12),PKW(pB0,14)};pw2=(u32x4){PKW(pB1,0),PKW(pB1,2),PKW(pB1,4),PKW(pB1,6)};pw3=(u32x4){PKW(pB1,8),PKW(pB1,10),PKW(pB1,12),PKW(pB1,14)};
    SBAR(); pv(o,vb0+sl_cur,PAF(0),PAF(1),PAF(2),PAF(3)); }
  #undef PKW
  #undef PAF
  #undef VFR
  #undef PIN
  #undef MX3
  #undef GAPA
  #undef GAPB
  #undef EX
  #undef VRD
  #undef KRD
  #undef STEP
  #undef ENDW
  {auto rr=__builtin_amdgcn_permlane32_swap(__float_as_uint(l_reg),__float_as_uint(l_reg),false,false);l_reg=__uint_as_float(rr[0])+__uint_as_float(rr[1]);}
  if(hi==0)wsf[32+r32]=l_reg;asm volatile("s_waitcnt lgkmcnt(0)":::"memory");
  float rli[16];
  #pragma unroll
  for(int r=0;r<16;++r)rli[r]=__builtin_amdgcn_rcpf(wsf[32+crow(r,hi)]);
  bf16*Ow=Ob+(long)(wid*QBLK)*pout;
  { bf16*stg=(bf16*)(shm+LDS_OST)+wid*2048;
    #pragma unroll
    for(int r=0;r<16;++r){const int orow=crow(r,hi);
      #pragma unroll
      for(int d0=0;d0<2;++d0)stg[orow*64+d0*32+r32]=__float2bfloat16(o[d0][r]*rli[r]);}
    asm volatile("s_waitcnt lgkmcnt(0)":::"memory");
    #pragma unroll
    for(int i=0;i<4;++i){const int row=i*8+(lane>>3),ch=lane&7; const u32x4 v=*(const u32x4*)(stg+row*64+ch*8); ATTN_STORE16(Ow+(long)row*pout+ch*8,v);} }
  asm volatile("s_waitcnt lgkmcnt(0)\n\ts_barrier":::"memory");
  #undef DMA_K
  #undef DMA_V
  #undef CMASK
  #undef START
  #undef RESC
  #undef ROT
}
constexpr int ATTN_LDS_BYTES=LDS_BYTES;
constexpr int U_LK=0, U_LVLO=24576, U_LVHI=49152, U_LWS=73728, U_LST=75776, U_LDS_BYTES=U_LST+NW*8192;
template<int THRL> __device__ __forceinline__ void attn_unit128(const bf16*Qb,const bf16*__restrict__ Kb,const bf16*__restrict__ Vb,bf16*Ob,const int pin,const int pout,const int NT,const float lam,const float*__restrict__ gsub,const float gscale,char*shm){
  const int tid=threadIdx.x,lane=tid&63,r32=lane&31,hi=lane>>5; const int wid=__builtin_amdgcn_readfirstlane(tid>>6);
  const unsigned lds0=(unsigned)(uintptr_t)shm;
  float*wsf=(float*)(shm+U_LWS)+wid*64;
  bf16*stg=(bf16*)(shm+U_LST)+wid*4096;
  const unsigned kdst=lds0+U_LK+wid*1024, vldst=lds0+U_LVLO+wid*1024, vhdst=lds0+U_LVHI+wid*1024;
  const int vbl=(int)(lds0+U_LVLO)+((lane>>4)&1)*32+(lane&3)*8+(4*hi+((lane&15)>>2))*64, vbh=vbl+(U_LVHI-U_LVLO);
  const bf16*vsrc=Vb+(long)(16*(wid&3)+(lane>>2))*pin+(wid>>2)*32+(lane&3)*8;
  #pragma unroll 1
  for(int sid=0;sid<2;++sid){
    const bf16*Qw=Qb+(long)(wid*QBLK)*pin+sid*64;
    const bf16*ksrc=Kb+sid*64+(long)lane*pin+wid*8;
    bf16x8 qr[4];
    #pragma unroll
    for(int d0=0;d0<4;++d0)qr[d0]=*reinterpret_cast<const bf16x8*>(&Qw[(long)r32*pin+d0*16+hi*8]);
    #define DMA3(t,slot) do{ const long off_=(long)(t)*KVBLK*pin; const unsigned so_=(unsigned)(slot)*SLOTB; \
      glds16(ksrc+off_,(unsigned)__builtin_amdgcn_readfirstlane(kdst+so_)); glds16(vsrc+off_,(unsigned)__builtin_amdgcn_readfirstlane(vldst+so_)); \
      glds16(vsrc+off_+64,(unsigned)__builtin_amdgcn_readfirstlane(vhdst+so_)); }while(0)
    DMA3(0,0); DMA3(1,1);
    float mhat=0.f,l_reg=0.f; f32x16 o[4];
    #pragma unroll
    for(int d=0;d<4;++d)o[d]=f32x16{};
    int slot=0;
    #pragma unroll 1
    for(int t=0;t<NT;++t){
      if(t+1<NT){WAIT_BAR(3);}else{WAIT_BAR(0);}
      if(t+2<NT){int s2=slot+2; if(s2>=3)s2-=3; DMA3(t+2,s2);}
      f32x16 p0,p1;
      { const f32x16 zc=f32x16{}; qkt(p0,p1,shm+U_LK+slot*SLOTB,qr,zc,r32,hi); }
      float rm;
      { float a=__builtin_fmaxf(__builtin_fmaxf(p0[0],p0[1]),p1[0]),b=__builtin_fmaxf(__builtin_fmaxf(p0[2],p0[3]),p1[1]); a=__builtin_fmaxf(__builtin_fmaxf(a,p1[2]),p1[3]);
        #pragma unroll
        for(int r=4;r<16;r+=4){a=__builtin_fmaxf(__builtin_fmaxf(a,p0[r]),p0[r+1]);b=__builtin_fmaxf(__builtin_fmaxf(b,p0[r+2]),p0[r+3]);a=__builtin_fmaxf(__builtin_fmaxf(a,p1[r]),p1[r+1]);b=__builtin_fmaxf(__builtin_fmaxf(b,p1[r+2]),p1[r+3]);}
        rm=__builtin_fmaxf(a,b); auto rr=__builtin_amdgcn_permlane32_swap(__float_as_uint(rm),__float_as_uint(rm),false,false); rm=__builtin_fmaxf(__uint_as_float(rr[0]),__uint_as_float(rr[1])); }
      const float ex_=rm-mhat;
      if(t==0 || __any(ex_>(float)THRL)){
        const float dl=(t==0)?rm:__builtin_fmaxf(ex_,0.f); mhat+=dl;
        if(t>0){ const float f=__builtin_amdgcn_exp2f(-dl); l_reg*=f; if(hi==0)wsf[r32]=f; asm volatile("s_waitcnt lgkmcnt(0)":::"memory");
          #pragma unroll
          for(int r=0;r<16;++r){const float fr_=wsf[crow(r,hi)];
            #pragma unroll
            for(int d=0;d<4;++d)o[d][r]*=fr_;} } }
      #pragma unroll
      for(int r=0;r<16;++r){p0[r]=__builtin_amdgcn_exp2f(p0[r]-mhat);p1[r]=__builtin_amdgcn_exp2f(p1[r]-mhat);}
      { float sa=0.f,sb=0.f;
        #pragma unroll
        for(int r=0;r<16;++r){sa+=p0[r];sb+=p1[r];}
        l_reg+=sa+sb; }
      u32x4 pw0,pw1,pw2,pw3;
      pw0=(u32x4){cvtpk_s(p0[0],p0[1]),cvtpk_s(p0[2],p0[3]),cvtpk_s(p0[4],p0[5]),cvtpk_s(p0[6],p0[7])};
      pw1=(u32x4){cvtpk_s(p0[8],p0[9]),cvtpk_s(p0[10],p0[11]),cvtpk_s(p0[12],p0[13]),cvtpk_s(p0[14],p0[15])};
      pw2=(u32x4){cvtpk_s(p1[0],p1[1]),cvtpk_s(p1[2],p1[3]),cvtpk_s(p1[4],p1[5]),cvtpk_s(p1[6],p1[7])};
      pw3=(u32x4){cvtpk_s(p1[8],p1[9]),cvtpk_s(p1[10],p1[11]),cvtpk_s(p1[12],p1[13]),cvtpk_s(p1[14],p1[15])};
      SBAR();
      pv(o,vbl+slot*SLOTB,__builtin_bit_cast(bf16x8,pw0),__builtin_bit_cast(bf16x8,pw1),__builtin_bit_cast(bf16x8,pw2),__builtin_bit_cast(bf16x8,pw3));
      pv(o+2,vbh+slot*SLOTB,__builtin_bit_cast(bf16x8,pw0),__builtin_bit_cast(bf16x8,pw1),__builtin_bit_cast(bf16x8,pw2),__builtin_bit_cast(bf16x8,pw3));
      slot=(slot==2)?0:slot+1;
    }
    #undef DMA3
    {auto rr=__builtin_amdgcn_permlane32_swap(__float_as_uint(l_reg),__float_as_uint(l_reg),false,false);l_reg=__uint_as_float(rr[0])+__uint_as_float(rr[1]);}
    if(hi==0)wsf[32+r32]=l_reg; asm volatile("s_waitcnt lgkmcnt(0)":::"memory");
    if(sid==0){
      #pragma unroll
      for(int r=0;r<16;++r){const int orow=crow(r,hi); const float rl=__builtin_amdgcn_rcpf(wsf[32+orow]);
        #pragma unroll
        for(int d=0;d<4;++d)stg[orow*128+d*32+r32]=__float2bfloat16(o[d][r]*rl);}
    } else {
      #pragma unroll
      for(int r=0;r<16;++r){const int orow=crow(r,hi); const float rl=__builtin_amdgcn_rcpf(wsf[32+orow]); float q=0.f;
        #pragma unroll
        for(int d=0;d<4;++d){const float v=__bfloat162float(stg[orow*128+d*32+r32])-lam*(o[d][r]*rl); o[d][r]=v; q+=v*v;}
        q+=__shfl_xor(q,1);q+=__shfl_xor(q,2);q+=__shfl_xor(q,4);q+=__shfl_xor(q,8);q+=__shfl_xor(q,16);
        const float rs=__builtin_amdgcn_rsqf(q*(1.0f/128.0f)+1e-6f);
        #pragma unroll
        for(int d=0;d<4;++d)stg[orow*128+d*32+r32]=__float2bfloat16(o[d][r]*rs*(gsub[32*d+r32]*gscale));}
      asm volatile("s_waitcnt lgkmcnt(0)":::"memory");
      bf16*Ow=Ob+(long)(wid*QBLK)*pout;
      #pragma unroll
      for(int i=0;i<8;++i){const int row=i*4+(lane>>4),ch=lane&15; const u32x4 v=*(const u32x4*)(stg+row*128+ch*8); *(u32x4*)(Ow+(long)row*pout+ch*8)=v;}
    }
    asm volatile("s_waitcnt lgkmcnt(0)\n\ts_barrier":::"memory");
  }
}
#define SWZX(v,k) __builtin_bit_cast(float,__builtin_amdgcn_ds_swizzle(__builtin_bit_cast(int,(v)),(((k)<<10)|0x1f)))
template<int THRL> __device__ __forceinline__ void attn_unit128p(const bf16*Qb,const bf16*__restrict__ Kb,const bf16*__restrict__ Vb,bf16*Ob,const int pin,const int pout,const int NT,const float lam,const float*__restrict__ gsub,const float gscale,char*shm){
  const int tid=threadIdx.x; int lane=tid&63; asm volatile("":"+v"(lane)); const int r32=lane&31,hi=lane>>5; const int wid=__builtin_amdgcn_readfirstlane(tid>>6);
  const unsigned lds0=(unsigned)(uintptr_t)shm;
  float*wsf=(float*)(shm+U_LWS)+wid*64;
  bf16*stg=(bf16*)(shm+U_LST)+wid*4096;
  const unsigned kdst=lds0+U_LK+wid*1024, vldst=lds0+U_LVLO+wid*1024, vhdst=lds0+U_LVHI+wid*1024;
  const bf16*vsrc=Vb+(long)(16*(wid&3)+(lane>>2))*pin+(wid>>2)*32+(lane&3)*8;
  const lds_cptr shm3=(lds_cptr)shm; const lds_cptr kp0=shm3+U_LK+hi*1024+r32*16;
  const lds_cptr vpl0=shm3+U_LVLO+((lane>>4)&1)*32+(lane&3)*8+(4*hi+((lane&15)>>2))*64;
  #pragma unroll 1
  for(int sid=0;sid<2;++sid){
    const bf16*Qw=Qb+(long)(wid*QBLK)*pin+sid*64;
    const bf16*ksrc=Kb+sid*64+(long)lane*pin+wid*8;
    bf16x8 qr[4];
    { int lq_=lane; asm volatile("":"+v"(lq_)); const bf16*qp_=Qw+(long)(lq_&31)*pin+(lq_>>5)*8;
      #pragma unroll
      for(int d0=0;d0<4;++d0)qr[d0]=*reinterpret_cast<const bf16x8*>(qp_+d0*16); }
    #define DMA_K(t,slot) glds16(ksrc+(long)(t)*KVBLK*pin,(unsigned)__builtin_amdgcn_readfirstlane(kdst+(slot)))
    #define DMA_V(t,slot) do{ glds16(vsrc+(long)(t)*KVBLK*pin,(unsigned)__builtin_amdgcn_readfirstlane(vldst+(slot))); glds16(vsrc+(long)(t)*KVBLK*pin+64,(unsigned)__builtin_amdgcn_readfirstlane(vhdst+(slot))); }while(0)
    DMA_K(0,0); DMA_K(1,SLOTB); DMA_V(0,0);
    float mhat=0.f,l_reg=0.f; f32x16 o[4];
    #pragma unroll
    for(int d=0;d<4;++d)o[d]=f32x16{};
    bool resc=false;
    f32x16 pA0,pA1,pB0,pB1; bf16x8 kf[8];
    int sl_prev=2*SLOTB,sl_cur=0,sl_next=SLOTB;
    #define ROT() do{const int t_=sl_prev;sl_prev=sl_cur;sl_cur=sl_next;sl_next=t_;}while(0)
    #define MX3(a,b,c) __builtin_fmaxf(__builtin_fmaxf((a),(b)),(c))
    #define ROWMAX(C0,C1,rm) do{ float a=MX3(C0[0],C0[1],C1[0]),b=MX3(C0[2],C0[3],C1[1]); a=MX3(a,C1[2],C1[3]); \
      _Pragma("unroll") for(int r=4;r<16;r+=4){a=MX3(a,C0[r],C0[r+1]);b=MX3(b,C0[r+2],C0[r+3]);a=MX3(a,C1[r],C1[r+1]);b=MX3(b,C1[r+2],C1[r+3]);} \
      rm=__builtin_fmaxf(a,b); { auto rr=__builtin_amdgcn_permlane32_swap(__float_as_uint(rm),__float_as_uint(rm),false,false); rm=__builtin_fmaxf(__uint_as_float(rr[0]),__uint_as_float(rr[1])); } }while(0)
    #define EXS(v) __builtin_amdgcn_exp2f(v)
    WAIT_BAR(3);
    DMA_K(2,2*SLOTB); DMA_V(1,SLOTB);
    kload8(kf,kp0);
    { const f32x16 zc=f32x16{};
      pA0=__builtin_amdgcn_mfma_f32_32x32x16_bf16(kf[0],qr[0],zc,0,0,0); pA1=__builtin_amdgcn_mfma_f32_32x32x16_bf16(kf[1],qr[0],zc,0,0,0);
      pA0=__builtin_amdgcn_mfma_f32_32x32x16_bf16(kf[2],qr[1],pA0,0,0,0); pA1=__builtin_amdgcn_mfma_f32_32x32x16_bf16(kf[3],qr[1],pA1,0,0,0);
      pA0=__builtin_amdgcn_mfma_f32_32x32x16_bf16(kf[4],qr[2],pA0,0,0,0); pA1=__builtin_amdgcn_mfma_f32_32x32x16_bf16(kf[5],qr[2],pA1,0,0,0);
      pA0=__builtin_amdgcn_mfma_f32_32x32x16_bf16(kf[6],qr[3],pA0,0,0,0); pA1=__builtin_amdgcn_mfma_f32_32x32x16_bf16(kf[7],qr[3],pA1,0,0,0); }
    f32x16 negm;
    { float rm; ROWMAX(pA0,pA1,rm); mhat=rm; }
    #pragma unroll
    for(int r=0;r<16;++r){pA0[r]=EXS(pA0[r]-mhat);pA1[r]=EXS(pA1[r]-mhat);}
    #pragma unroll
    for(int r=0;r<16;++r)negm[r]=-mhat;
    asm volatile("":"+v"(negm));
    ROT();
    s16x4 vlo[8],vhi[8],wlo[8],whi[8]; u32x4 pw0,pw1,pw2,pw3;
    #define PKW(P,B) cvtpk_s(P[B],P[B+1])
    #define PAF(k) __builtin_bit_cast(bf16x8,pw##k)
    #define VFR(i) (bf16x8){vlo[i][0],vlo[i][1],vlo[i][2],vlo[i][3],vhi[i][0],vhi[i][1],vhi[i][2],vhi[i][3]}
    #define WFR(i) (bf16x8){wlo[i][0],wlo[i][1],wlo[i][2],wlo[i][3],whi[i][0],whi[i][1],whi[i][2],whi[i][3]}
    #define PIN(x) asm volatile("":"+v"(x))
    #define GAPA(MF,A0,A1,A2,A3,W0,W1,PW) do{ MF; sacc+=A0; sacc+=A1; sacc+=A2; sacc+=A3; PIN(sacc); W0; W1; PIN(PW); SBAR(); }while(0)
    #define GAPB(MF,X,B) do{ MF; X[B]=EXS(X[B]); X[B+1]=EXS(X[B+1]); PIN(X); SBAR(); }while(0)
    #define VRD(i) do{ vlo[i]=vtr(vp_+(((i)>>2)*4096+((i)&3)*1024)); vhi[i]=vtr(vp_+(((i)>>2)*4096+((i)&3)*1024+512)); }while(0)
    #define WRD(i) do{ wlo[i]=vtr(vq_+(((i)>>2)*4096+((i)&3)*1024)); whi[i]=vtr(vq_+(((i)>>2)*4096+((i)&3)*1024+512)); }while(0)
    #define MFQ(C,k,q,CI) C=__builtin_amdgcn_mfma_f32_32x32x16_bf16(kf[k],qr[q],CI,0,0,0)
    #define MFO(d,k,VF) o[d]=__builtin_amdgcn_mfma_f32_32x32x16_bf16(PAF(k),VF,o[d],0,0,0)
    #define PHASEA(C0,C1,P0,P1) do{ SBAR(); \
      const lds_cptr vp_=vpl0+sl_prev; \
      kload8(kf,kp0+sl_cur); SBAR(); \
      VRD(0); SBAR(); float sacc=(P0[0]+P0[1]); \
      GAPA(MFQ(C0,0,0,negm), P0[2],P0[3],P0[4],P0[5],     pw0[0]=PKW(P0,0), pw0[1]=PKW(P0,2), pw0); \
      VRD(4); SBAR(); GAPA(MFQ(C1,1,0,negm), P0[6],P0[7],P0[8],P0[9],     pw0[2]=PKW(P0,4), pw0[3]=PKW(P0,6), pw0); \
      VRD(1); SBAR(); GAPA(MFQ(C0,2,1,C0), P0[10],P0[11],P0[12],P0[13], pw1[0]=PKW(P0,8), pw1[1]=PKW(P0,10), pw1); \
      VRD(5); SBAR(); GAPA(MFQ(C1,3,1,C1), P0[14],P0[15],P1[0],P1[1],   pw1[2]=PKW(P0,12),pw1[3]=PKW(P0,14), pw1); \
      VRD(2); SBAR(); GAPA(MFQ(C0,4,2,C0), P1[2],P1[3],P1[4],P1[5],     pw2[0]=PKW(P1,0), pw2[1]=PKW(P1,2), pw2); \
      VRD(6); SBAR(); GAPA(MFQ(C1,5,2,C1), P1[6],P1[7],P1[8],P1[9],     pw2[2]=PKW(P1,4), pw2[3]=PKW(P1,6), pw2); \
      VRD(3); SBAR(); GAPA(MFQ(C0,6,3,C0), P1[10],P1[11],P1[12],P1[13], pw3[0]=PKW(P1,8), pw3[1]=PKW(P1,10), pw3); \
      VRD(7); SBAR(); GAPA(MFQ(C1,7,3,C1), P1[14],P1[15],0.f,0.f,       pw3[2]=PKW(P1,12),pw3[3]=PKW(P1,14), pw3); \
      l_reg+=sacc; \
      { float rm; ROWMAX(C0,C1,rm); resc=false; \
        if(__builtin_expect(__any(rm>(float)THRL),0)){ const float dl=__builtin_fmaxf(rm,0.f); mhat+=dl; \
          _Pragma("unroll") for(int r=0;r<16;++r){C0[r]-=dl;C1[r]-=dl;} \
          _Pragma("unroll") for(int r=0;r<16;++r)negm[r]=-mhat; asm volatile("":"+v"(negm)); \
          const float f=__builtin_amdgcn_exp2f(-dl); l_reg*=f; if(hi==0)wsf[r32]=f; resc=true; } } \
      SBAR(); }while(0)
    #define PHASEB(C0,C1) do{ const lds_cptr vq_=vpl0+(U_LVHI-U_LVLO)+sl_prev; \
      WRD(0); SBAR(); GAPB(MFO(0,0,VFR(0)), C0,0); \
      WRD(4); SBAR(); GAPB(MFO(1,0,VFR(4)), C0,2); \
      WRD(1); SBAR(); GAPB(MFO(0,1,VFR(1)), C0,4); \
      WRD(5); SBAR(); GAPB(MFO(1,1,VFR(5)), C0,6); \
      WRD(2); SBAR(); GAPB(MFO(0,2,VFR(2)), C0,8); \
      WRD(6); SBAR(); GAPB(MFO(1,2,VFR(6)), C0,10); \
      WRD(3); SBAR(); GAPB(MFO(0,3,VFR(3)), C0,12); \
      WRD(7); SBAR(); GAPB(MFO(1,3,VFR(7)), C0,14); \
      GAPB(MFO(2,0,WFR(0)), C1,0); GAPB(MFO(3,0,WFR(4)), C1,2); GAPB(MFO(2,1,WFR(1)), C1,4); GAPB(MFO(3,1,WFR(5)), C1,6); \
      GAPB(MFO(2,2,WFR(2)), C1,8); GAPB(MFO(3,2,WFR(6)), C1,10); GAPB(MFO(2,3,WFR(3)), C1,12); GAPB(MFO(3,3,WFR(7)), C1,14); }while(0)
    #define RESC() do{ if(resc){ asm volatile("s_waitcnt lgkmcnt(0)":::"memory"); \
      _Pragma("unroll") for(int r=0;r<16;++r){ const float fr_=wsf[crow(r,hi)]; _Pragma("unroll") for(int d_=0;d_<4;++d_) o[d_][r]*=fr_; } } }while(0)
    #define STEP(C0,C1,P0,P1,t) do{ if((t)+2<=NT){WAIT_BAR(3);}else{WAIT_BAR(2);} \
      if((t)+2<NT){DMA_K((t)+2,sl_prev);} if((t)+1<NT){DMA_V((t)+1,sl_next);} \
      PHASEA(C0,C1,P0,P1); PHASEB(C0,C1); RESC(); ROT(); }while(0)
    int t=1;
    if(wid>=4)__builtin_amdgcn_s_setprio(1);
    #pragma unroll 1
    for(;t+1<NT;t+=2){ STEP(pB0,pB1,pA0,pA1,t); STEP(pA0,pA1,pB0,pB1,t+1); }
    STEP(pB0,pB1,pA0,pA1,NT-1);
    __builtin_amdgcn_s_setprio(0);
    WAIT_BAR(0);
    { float sacc=pB0[0]+pB0[1];
      #pragma unroll
      for(int r=2;r<16;++r)sacc+=pB0[r];
      #pragma unroll
      for(int r=0;r<16;++r)sacc+=pB1[r];
      l_reg+=sacc;
      pw0=(u32x4){PKW(pB0,0),PKW(pB0,2),PKW(pB0,4),PKW(pB0,6)};pw1=(u32x4){PKW(pB0,8),PKW(pB0,10),PKW(pB0,12),PKW(pB0,14)};pw2=(u32x4){PKW(pB1,0),PKW(pB1,2),PKW(pB1,4),PKW(pB1,6)};pw3=(u32x4){PKW(pB1,8),PKW(pB1,10),PKW(pB1,12),PKW(pB1,14)};
      SBAR(); const int vbl=(int)(lds0+U_LVLO)+((lane>>4)&1)*32+(lane&3)*8+(4*hi+((lane&15)>>2))*64+sl_prev;
      pv(o,vbl,PAF(0),PAF(1),PAF(2),PAF(3)); pv(o+2,vbl+(U_LVHI-U_LVLO),PAF(0),PAF(1),PAF(2),PAF(3)); }
    #undef DMA_K
    #undef DMA_V
    #undef ROT
    #undef MX3
    #undef ROWMAX
    #undef EXS
    #undef PKW
    #undef PAF
    #undef VFR
    #undef WFR
    #undef PIN
    #undef GAPA
    #undef GAPB
    #undef VRD
    #undef WRD
    #undef MFQ
    #undef MFO
    #undef PHASEA
    #undef PHASEB
    #undef RESC
    #undef STEP
    {auto rr=__builtin_amdgcn_permlane32_swap(__float_as_uint(l_reg),__float_as_uint(l_reg),false,false);l_reg=__uint_as_float(rr[0])+__uint_as_float(rr[1]);}
    int le_=lane; asm volatile("":"+v"(le_)); const int r32e=le_&31, hie=le_>>5;
    if(hie==0)wsf[32+r32e]=l_reg; asm volatile("s_waitcnt lgkmcnt(0)":::"memory");
    if(sid==0){
      #pragma unroll
      for(int r=0;r<16;++r){const int orow=crow(r,hie); const float rl=__builtin_amdgcn_rcpf(wsf[32+orow]);
        #pragma unroll
        for(int d=0;d<4;++d)stg[orow*128+d*32+r32e]=__float2bfloat16(o[d][r]*rl);}
    } else {
      float gl_[4];
      #pragma unroll
      for(int d=0;d<4;++d)gl_[d]=gsub[32*d+r32e]*gscale;
      #pragma unroll
      for(int r=0;r<16;++r){const int orow=crow(r,hie); const float rl=__builtin_amdgcn_rcpf(wsf[32+orow]); float q=0.f;
        #pragma unroll
        for(int d=0;d<4;++d){const float v=__bfloat162float(stg[orow*128+d*32+r32e])-lam*(o[d][r]*rl); o[d][r]=v; q+=v*v;}
        q+=SWZX(q,1);q+=SWZX(q,2);q+=SWZX(q,4);q+=SWZX(q,8);q+=SWZX(q,16);
        const float rs=__builtin_amdgcn_rsqf(q*(1.0f/128.0f)+1e-6f);
        #pragma unroll
        for(int d=0;d<4;++d)stg[orow*128+d*32+r32e]=__float2bfloat16(o[d][r]*rs*gl_[d]);}
      asm volatile("s_waitcnt lgkmcnt(0)":::"memory");
      bf16*Ow=Ob+(long)(wid*QBLK)*pout;
      #pragma unroll
      for(int i=0;i<8;++i){const int row=i*4+(le_>>4),ch=le_&15; const u32x4 v=*(const u32x4*)(stg+row*128+ch*8); *(u32x4*)(Ow+(long)row*pout+ch*8)=v;}
    }
    asm volatile("s_waitcnt lgkmcnt(0)\n\ts_barrier":::"memory");
  }
}
#undef SBAR
#undef WAIT_BAR
}
constexpr int NWAVES = 8;
constexpr int SEQ = 8192, NBATCH = 2, M = NBATCH * SEQ, D = 1024, FF = 2816, NI0 = 2304, NI1 = 3072;
constexpr float RMS_EPS = 1e-6f, LAM_INIT = 0.35550906f;
constexpr size_t MiB = 1u << 20;
constexpr size_t WS_CTL = 0, CTL_ZERO_BYTES = 1 * MiB;
constexpr size_t WS_SS = 512 * 1024;
constexpr size_t WS_WIN0 = 2 * MiB, WS_WO0 = WS_WIN0 + (size_t)NI0 * D * 2, WS_WIN1 = WS_WO0 + (size_t)D * D * 2, WS_WO1 = WS_WIN1 + (size_t)NI1 * D * 2,
                 WS_WGU0 = WS_WO1 + (size_t)D * D * 2, WS_WGU1 = WS_WGU0 + (size_t)2 * FF * D * 2, WS_WD0 = WS_WGU1 + (size_t)2 * FF * D * 2,
                 WS_WD1 = WS_WD0 + (size_t)FF * D * 2, WS_WEND = WS_WD1 + (size_t)FF * D * 2;
static_assert(WS_WEND <= 50 * MiB, "weights");
constexpr size_t WS_TAB = 50 * MiB;
constexpr size_t WS_XB = 64 * MiB, WS_PROJ = 96 * MiB, WS_H = 96 * MiB, WS_OC = 192 * MiB, WS_O = 192 * MiB, WS_END = 256 * MiB;
constexpr int CW_TMO = 0, CW_CODE = 1, CW_BAR = 4096;
constexpr int RING_OFF = 0, RING_BYTES = 146432;
constexpr int LDSCTL_OFF = RING_BYTES, MISC_OFF = LDSCTL_OFF + 320;
constexpr int LDS_BYTES = 147456;

#define GAS __attribute__((address_space(1)))
#define LAS __attribute__((address_space(3)))
typedef unsigned short bf16;
typedef unsigned v4u __attribute__((ext_vector_type(4)));
typedef float f32x4 __attribute__((ext_vector_type(4)));
typedef short bf16x8 __attribute__((ext_vector_type(8)));
typedef GAS unsigned gu32;
typedef GAS unsigned long long gu64;
#define RLX_AGENT __ATOMIC_RELAXED, __HIP_MEMORY_SCOPE_AGENT
#define LDS_WAIT() asm volatile("s_waitcnt lgkmcnt(0)" ::: "memory")
#define VM_WAIT() asm volatile("s_waitcnt vmcnt(0)" ::: "memory")
__device__ __forceinline__ unsigned long long rt() { return __builtin_amdgcn_s_memrealtime(); }
__device__ __forceinline__ unsigned f2bf(float f) { unsigned u = __builtin_bit_cast(unsigned, f); return (u + 0x7fffu + ((u >> 16) & 1u)) >> 16; }
__device__ __forceinline__ unsigned pk2(float lo, float hi) { return f2bf(lo) | (f2bf(hi) << 16); }

#define XB_TMO      128
#define XB_XCNT(j)  (256  + 64 * (j))
#define XB_XSUB(j)  (1280 + 64 * (j))
#define XB_XGEN(j)  (2304 + 64 * (j))
#define XB_TOP      3328
#define XB_TOPGEN   3392
#define XCD_BAR_WORDS 3456
#define XB_SPIN_CAP (1u << 18)

__device__ __forceinline__ unsigned xb_ld(unsigned* p)              { return __hip_atomic_load(p, __ATOMIC_RELAXED, __HIP_MEMORY_SCOPE_AGENT); }
__device__ __forceinline__ unsigned xb_add(unsigned* p, unsigned v) { return __hip_atomic_fetch_add(p, v, __ATOMIC_RELAXED, __HIP_MEMORY_SCOPE_AGENT); }
__device__ __forceinline__ unsigned xb_xcc_id() { return (unsigned)__builtin_amdgcn_s_getreg((3 << 11) | 20) & 0xFu; }
#define XB_SPIN(cond, bar) do { unsigned _sp = 0; while (cond) { __builtin_amdgcn_s_sleep(1); \
    if ((++_sp & 255u) == 0u) { if (xb_ld(&(bar)[XB_TMO])) break; if (_sp > XB_SPIN_CAP) { atomicAdd(&(bar)[XB_TMO], 1u); break; } } } } while (0)

struct XcdBarrier {
    unsigned* bar; unsigned x;
    volatile LAS unsigned* st;
};

__device__ __forceinline__ XcdBarrier xcd_barrier_post(unsigned* bar, volatile LAS unsigned* st) {
    XcdBarrier b; b.bar = bar; b.x = xb_xcc_id(); b.st = st;
    if (threadIdx.x == 0) (void)xb_add(&bar[XB_XCNT(b.x)], 1u);
    return b;
}
__device__ __forceinline__ void xcd_barrier_complete(unsigned* bar, unsigned x, unsigned& nloc, unsigned& nx) {
    const unsigned G = gridDim.x * gridDim.y * gridDim.z;
    unsigned sum, cnt, mine, sp = 0u;
    for (;;) {
        sum = 0u; cnt = 0u; mine = 0u;
#pragma unroll
        for (unsigned j = 0; j < 16; ++j) { const unsigned c = xb_ld(&bar[XB_XCNT(j)]); sum += c; cnt += (c > 0u) ? 1u : 0u; mine = (j == x) ? c : mine; }
        if (sum == G) break;
        __builtin_amdgcn_s_sleep(1);
        if ((++sp & 255u) == 0u) { if (xb_ld(&bar[XB_TMO])) break; if (sp > XB_SPIN_CAP) { atomicAdd(&bar[XB_TMO], 1u); break; } }
    }
    nloc = mine > 0u ? mine : 1u; nx = cnt > 0u ? cnt : 1u;
}

__device__ __forceinline__ void xcd_barrier(const XcdBarrier& b) {
    asm volatile("s_waitcnt vmcnt(0)" ::: "memory");
    __syncthreads();
    if (threadIdx.x == 0) {
        unsigned* bar = b.bar;
        __builtin_amdgcn_s_waitcnt(0);
        unsigned nloc = b.st[0], nx = b.st[1];
        if (nloc == 0u) { xcd_barrier_complete(bar, b.x, nloc, nx); b.st[0] = nloc; b.st[1] = nx; }
        const unsigned old = xb_add(&bar[XB_XSUB(b.x)], 1u);
        const unsigned gen = old / nloc;
        if (old + 1u == (gen + 1u) * nloc) {
            __builtin_amdgcn_fence(__ATOMIC_RELEASE, "agent");
            asm volatile("s_waitcnt vmcnt(0)" ::: "memory");
            const unsigned og = xb_add(&bar[XB_TOP], 1u);
            const unsigned tg = og / nx;
            if (og + 1u == (tg + 1u) * nx) xb_add(&bar[XB_TOPGEN], 1u);
            else XB_SPIN(xb_ld(&bar[XB_TOPGEN]) == tg, bar);
            __builtin_amdgcn_fence(__ATOMIC_ACQUIRE, "agent");
            xb_add(&bar[XB_XGEN(b.x)], 1u);
            asm volatile("s_waitcnt vmcnt(0)" ::: "memory");
        } else {
            XB_SPIN(xb_ld(&bar[XB_XGEN(b.x)]) == gen, bar);
            __builtin_amdgcn_fence(__ATOMIC_ACQUIRE, "agent");
            asm volatile("s_waitcnt vmcnt(0)" ::: "memory");
        }
    }
    __syncthreads();
}
struct Frame {
    LAS unsigned char* lds;
    volatile LAS unsigned* MISC;
    gu32* ctl;
    int tid, lane, wave;
    int vcu, G;
    const float* in[18]; float* out; unsigned char* ws;
};
__device__ __forceinline__ float wave_sum(float v) {
#pragma unroll
    for (int o = 1; o < 64; o <<= 1) v += __shfl_xor(v, o);
    return v;
}
__device__ __forceinline__ float bf2f(unsigned b) { return __uint_as_float(b << 16); }
__device__ __forceinline__ void p0_transpose_item(const float* W, const float* gain, int K, int N, bf16* WT, int kb, int nb, int dst_row0, LAS float* scr, int lane) {
    const int k0 = 64 * kb, n0 = 32 * nb;
#pragma unroll 8
    for (int i = 0; i < 32; ++i) { const int kk = 2 * i + (lane >> 5); float w = W[(size_t)(k0 + kk) * N + n0 + (lane & 31)]; if (gain) w *= gain[k0 + kk]; scr[kk * 33 + (lane & 31)] = w; }
    LDS_WAIT(); asm volatile("" ::: "memory");
    const int c = lane & 7;
#pragma unroll
    for (int j = 0; j < 4; ++j) { const int n = (lane >> 3) + 8 * j; const LAS float* s = scr + (8 * c) * 33 + n;
        v4u o; o.x = pk2(s[0 * 33], s[1 * 33]); o.y = pk2(s[2 * 33], s[3 * 33]); o.z = pk2(s[4 * 33], s[5 * 33]); o.w = pk2(s[6 * 33], s[7 * 33]);
        *(GAS v4u*)(WT + (size_t)(dst_row0 + n) * K + k0 + 8 * c) = o; }
    LDS_WAIT(); asm volatile("" ::: "memory");
}
__device__ __forceinline__ void cvt_rows(Frame& F, const float* src, bf16* XB, float* ss) {
    const int gw = F.vcu * NWAVES + F.wave, NGW = F.G * NWAVES;
    for (int m = gw; m < M; m += NGW) {
        const GAS f32x4* xr = (const GAS f32x4*)(src + (size_t)m * D) + F.lane;
        f32x4 v[4]; float s = 0.f;
#pragma unroll
        for (int j = 0; j < 4; ++j) { v[j] = xr[64 * j]; s += (v[j].x * v[j].x + v[j].y * v[j].y) + (v[j].z * v[j].z + v[j].w * v[j].w); }
        s = wave_sum(s);
        GAS unsigned long long* o8 = (GAS unsigned long long*)(XB + (size_t)m * D) + F.lane;
#pragma unroll
        for (int j = 0; j < 4; ++j) o8[64 * j] = (unsigned long long)pk2(v[j].x, v[j].y) | ((unsigned long long)pk2(v[j].z, v[j].w) << 32);
        if (F.lane == 0) ss[m] = s;
    }
}
__device__ __forceinline__ void p0_prologue(Frame& F) {
    LAS float* scr = (LAS float*)(F.lds + RING_OFF + F.wave * 16384);
    const int gw = F.vcu * NWAVES + F.wave, NGW = F.G * NWAVES;
    constexpr int I_IN0 = 16 * (NI0 / 32), I_O = 16 * (D / 32), I_IN1 = 16 * (NI1 / 32), I_G = 16 * (FF / 32), I_D = (FF / 64) * (D / 32);
    constexpr int NITEMS = I_IN0 + I_O + I_IN1 + I_O + 2 * (2 * I_G + I_D);
    const float* attn_norm = F.in[1]; const float* ffn_norm = F.in[2];
    for (int it = gw; it < NITEMS; it += NGW) {
        int r = it;
        if (r < I_IN0) { const int nbk = NI0 / 32; p0_transpose_item(F.in[4], attn_norm, D, NI0, (bf16*)(F.ws + WS_WIN0), r / nbk, r % nbk, 32 * (r % nbk), scr, F.lane); continue; } r -= I_IN0;
        if (r < I_O) { const int nbk = D / 32; p0_transpose_item(F.in[7], nullptr, D, D, (bf16*)(F.ws + WS_WO0), r / nbk, r % nbk, 32 * (r % nbk), scr, F.lane); continue; } r -= I_O;
        if (r < I_IN1) { const int nbk = NI1 / 32; p0_transpose_item(F.in[8], attn_norm + D, D, NI1, (bf16*)(F.ws + WS_WIN1), r / nbk, r % nbk, 32 * (r % nbk), scr, F.lane); continue; } r -= I_IN1;
        if (r < I_O) { const int nbk = D / 32; p0_transpose_item(F.in[14], nullptr, D, D, (bf16*)(F.ws + WS_WO1), r / nbk, r % nbk, 32 * (r % nbk), scr, F.lane); continue; } r -= I_O;
        const int l = r / (2 * I_G + I_D); r -= l * (2 * I_G + I_D);
        if (r < 2 * I_G) { const int up = r / I_G; r -= up * I_G; const int nbk = FF / 32, nb = r % nbk, n0 = 32 * nb;
            p0_transpose_item((up ? F.in[16] : F.in[15]) + (size_t)l * D * FF, ffn_norm + l * D, D, FF, (bf16*)(F.ws + (l ? WS_WGU1 : WS_WGU0)), r / nbk, nb, (n0 / 128) * 256 + (n0 % 128) + up * 128, scr, F.lane); continue; }
        r -= 2 * I_G;
        { const int nbk = D / 32; p0_transpose_item(F.in[17] + (size_t)l * FF * D, nullptr, FF, D, (bf16*)(F.ws + (l ? WS_WD1 : WS_WD0)), r / nbk, r % nbk, 32 * (r % nbk), scr, F.lane); }
    }
    { float* tab = (float*)(F.ws + WS_TAB); const int gt = (F.vcu * NWAVES + F.wave) * 64 + F.lane, NGT = F.G * NWAVES * 64;
      for (int idx = gt; idx < SEQ * 32; idx += NGT) { const int t = idx >> 5, i = idx & 31;
          const float a1 = (float)t * powf(10000.f, -(float)(2 * i) / 64.f);
          const float a2 = (float)(i < 16 ? (t >> 6) : (t & 63)) * powf(10000.f, -(float)(2 * (i & 15)) / 32.f);
          float s1, c1, s2, c2; sincosf(a1, &s1, &c1); sincosf(a2, &s2, &c2);
          tab[idx] = c1; tab[SEQ * 32 + idx] = s1; tab[2 * SEQ * 32 + idx] = c2; tab[3 * SEQ * 32 + idx] = s2; } }
    cvt_rows(F, F.in[0], (bf16*)(F.ws + WS_XB), (float*)(F.ws + WS_SS));
}
template <int LAYER> __device__ __forceinline__ void rope_phase(Frame& F) {
    constexpr int pitch = LAYER == 0 ? NI0 : NI1, NIT = LAYER == 0 ? 9 : 8;
    const float* tab = (const float*)(F.ws + WS_TAB);
    const float* qn = F.in[5]; const float* kn = F.in[6];
    bf16* P = (bf16*)(F.ws + WS_PROJ);
    const int gw = F.vcu * NWAVES + F.wave, NGW = F.G * NWAVES;
    const int sub = F.lane >> 4, d0 = (F.lane & 15) * 4, i0 = d0 & 31;
    f32x4 gq = (f32x4){1.f, 1.f, 1.f, 1.f}, gk = gq;
    if (LAYER == 0) { gq = *(const f32x4*)(qn + d0); gk = *(const f32x4*)(kn + d0); }
    for (int row = gw; row < M; row += NGW) {
        const int t = row & (SEQ - 1);
        const f32x4 c1 = *(const f32x4*)(tab + t * 32 + i0), s1 = *(const f32x4*)(tab + SEQ * 32 + t * 32 + i0);
        f32x4 c2 = c1, s2 = s1;
        if (LAYER == 0) { c2 = *(const f32x4*)(tab + 2 * SEQ * 32 + t * 32 + i0); s2 = *(const f32x4*)(tab + 3 * SEQ * 32 + t * 32 + i0); }
        bf16* prow = P + (size_t)row * pitch;
#pragma unroll
        for (int it = 0; it < NIT; ++it) {
            const int head = it * 4 + sub;
            int mode; float scale = 1.f;
            if (LAYER == 0) { mode = head < 8 ? 2 : head < 10 ? 3 : head < 12 ? 0 : head < 28 ? 1 : 0; if (head < 8 || (head >= 12 && head < 20)) scale = attn_body::C2; }
            else { mode = 1; if (head < 16) scale = attn_body::C2; }
            GAS unsigned long long* pp = (GAS unsigned long long*)(prow + head * 64 + d0);
            const unsigned long long raw = *pp;
            f32x4 y = (f32x4){bf2f((unsigned)raw & 0xffffu), bf2f(((unsigned)raw >> 16) & 0xffffu), bf2f((unsigned)(raw >> 32) & 0xffffu), bf2f((unsigned)(raw >> 48) & 0xffffu)};
            if (LAYER == 0) { float q = (y.x * y.x + y.y * y.y) + (y.z * y.z + y.w * y.w);
                q += __shfl_xor(q, 1); q += __shfl_xor(q, 2); q += __shfl_xor(q, 4); q += __shfl_xor(q, 8);
                const float r = rsqrtf(q * (1.f / 64.f) + RMS_EPS);
                if (mode == 2) y = y * r * gq; else if (mode == 3) y = y * r * gk; }
            const f32x4 c = (mode == 1) ? c1 : c2, s = (mode == 1) ? s1 : s2;
            f32x4 o; o.x = __shfl_xor(y.x, 8); o.y = __shfl_xor(y.y, 8); o.z = __shfl_xor(y.z, 8); o.w = __shfl_xor(y.w, 8);
            const f32x4 res = ((d0 < 32) ? (y * c - o * s) : (o * s + y * c)) * scale;
            if (mode) *pp = (unsigned long long)pk2(res.x, res.y) | ((unsigned long long)pk2(res.z, res.w) << 32);
        }
    }
}
__device__ __forceinline__ void combine_phase(Frame& F) {
    const int gw = F.vcu * NWAVES + F.wave, NGW = F.G * NWAVES;
    const float sa = wave_sum(F.in[9][F.lane] * F.in[10][F.lane]), sb = wave_sum(F.in[11][F.lane] * F.in[12][F.lane]);
    const float lam = expf(sa) - expf(sb) + LAM_INIT;
    const float* gs = F.in[13] + (F.lane & 7) * 16;
    const f32x4 g0 = *(const f32x4*)(gs), g1 = *(const f32x4*)(gs + 4), g2 = *(const f32x4*)(gs + 8), g3 = *(const f32x4*)(gs + 12);
    const bf16* O2 = (const bf16*)(F.ws + WS_O); bf16* OC = (bf16*)(F.ws + WS_OC);
    for (int row = gw; row < M; row += NGW) {
        const GAS v4u* p1 = (const GAS v4u*)(O2 + (size_t)row * 2048 + F.lane * 16); const GAS v4u* p2 = (const GAS v4u*)(O2 + (size_t)row * 2048 + 1024 + F.lane * 16);
        const v4u a0 = p1[0], a1 = p1[1], b0 = p2[0], b1 = p2[1];
        float o[16];
#pragma unroll
        for (int j = 0; j < 4; ++j) { o[2 * j] = bf2f(a0[j] & 0xffffu) - lam * bf2f(b0[j] & 0xffffu); o[2 * j + 1] = bf2f(a0[j] >> 16) - lam * bf2f(b0[j] >> 16);
                                      o[8 + 2 * j] = bf2f(a1[j] & 0xffffu) - lam * bf2f(b1[j] & 0xffffu); o[8 + 2 * j + 1] = bf2f(a1[j] >> 16) - lam * bf2f(b1[j] >> 16); }
        float q = 0.f;
#pragma unroll
        for (int j = 0; j < 16; ++j) q += o[j] * o[j];
        q += __shfl_xor(q, 1); q += __shfl_xor(q, 2); q += __shfl_xor(q, 4);
        const float r = rsqrtf(q * (1.f / 128.f) + RMS_EPS) * (1.0f - LAM_INIT);
        v4u w0, w1;
        w0.x = pk2(o[0] * r * g0.x, o[1] * r * g0.y); w0.y = pk2(o[2] * r * g0.z, o[3] * r * g0.w); w0.z = pk2(o[4] * r * g1.x, o[5] * r * g1.y); w0.w = pk2(o[6] * r * g1.z, o[7] * r * g1.w);
        w1.x = pk2(o[8] * r * g2.x, o[9] * r * g2.y); w1.y = pk2(o[10] * r * g2.z, o[11] * r * g2.w); w1.z = pk2(o[12] * r * g3.x, o[13] * r * g3.y); w1.w = pk2(o[14] * r * g3.z, o[15] * r * g3.w);
        GAS v4u* po = (GAS v4u*)(OC + (size_t)row * 1024 + F.lane * 16); po[0] = w0; po[1] = w1;
    }
}
__device__ __forceinline__ void final_norm_phase(Frame& F) {
    const int gw = F.vcu * NWAVES + F.wave, NGW = F.G * NWAVES;
    const float* ss = (const float*)(F.ws + WS_SS) + 4 * M; const GAS f32x4* g = (const GAS f32x4*)F.in[3] + F.lane;
    for (int m = gw; m < M; m += NGW) {
        const float r = rsqrtf(ss[m] * (1.f / 1024.f) + RMS_EPS);
        GAS f32x4* xr = (GAS f32x4*)(F.out + (size_t)m * D) + F.lane;
#pragma unroll
        for (int j = 0; j < 4; ++j) xr[64 * j] = xr[64 * j] * r * g[64 * j];
    }
}
template <int LAYER> __device__ __forceinline__ void attention_phase(Frame& F, char* lds) {
    using abf = attn_body::bf16;
    const abf* P = (const abf*)(F.ws + WS_PROJ); abf* O = (abf*)(F.ws + WS_O);
    if (LAYER == 0) {
        LAS float* tb = (LAS float*)(F.lds + attn_body::DTBL_OFF);
        for (int idx = F.tid; idx < attn_body::DTBL_N; idx += NWAVES * 64) { const int off = idx - 1280, ao = off < 0 ? -off : off;
            const int mm = (ao <= 64 ? 1 : 0) + ((((off & 3) == 0) && ao <= 256) ? 1 : 0) + ((((off & 15) == 0) && ao <= 1024) ? 1 : 0);
            tb[idx] = mm == 0 ? -1000.f : (mm == 1 ? 0.f : (mm == 2 ? 1.f : 1.5849625007f)); }
        __syncthreads();
        for (int i = 0;; ++i) { const int U = i * F.G + F.vcu; if (U >= 1024) break;
            const int ii = U >> 8, v = U & 255, bh = v >> 4, s = v & 15, b = bh >> 3, h = bh & 7, qb = (ii & 1) ? 31 - s : s, q0 = qb * 256; const size_t rowb = (size_t)b * SEQ;
            if (ii < 2) attn_body::attn_unit<8, 0>(P + (rowb + q0) * NI0 + h * 64, P + rowb * NI0 + 512 + (h >> 2) * 64, P + rowb * NI0 + 640 + (h >> 2) * 64, O + (rowb + q0) * 1024 + h * 64, NI0, 1024, 128, 0, lds);
            else { const int tlo = (q0 - 1024 < 0 ? 0 : q0 - 1024) / 64, thi = (q0 + 1280 > SEQ ? SEQ : q0 + 1280) / 64;
                attn_body::attn_unit<8, 1>(P + (rowb + q0) * NI0 + 768 + h * 64, P + (rowb + 64 * tlo) * NI0 + 1280 + h * 64, P + (rowb + 64 * tlo) * NI0 + 1792 + h * 64, O + (rowb + q0) * 1024 + 512 + h * 64, NI0, 1024, thi - tlo, 64 * tlo - q0, lds); } }
    } else {
        static_assert(attn_body::U_LDS_BYTES <= RING_BYTES, "diff-attention unit LDS");
        float sa = 0.f, sb = 0.f;
        for (int i = 0; i < 64; ++i) { sa += F.in[9][i] * F.in[10][i]; sb += F.in[11][i] * F.in[12][i]; }
        const float lam = expf(sa) - expf(sb) + LAM_INIT;
        for (int i = 0;; ++i) { const int U = i * F.G + F.vcu; if (U >= 512) break;
            const int ii = U >> 8, v = U & 255, bh = v >> 4, b = bh >> 3, h = bh & 7, qb = (v & 15) + 16 * ii, q0 = qb * 256; const size_t rowb = (size_t)b * SEQ;
            attn_body::attn_unit128p<8>(P + (rowb + q0) * NI1 + h * 128, P + rowb * NI1 + 1024 + h * 128, P + rowb * NI1 + 2048 + h * 128,
                                       O + (rowb + q0) * 1024 + h * 128, NI1, 1024, 128, lam, F.in[13], 1.0f - LAM_INIT, lds); }
    }
}

struct Args { const float* in[18]; float* out; unsigned char* ws; int ph_lo, ph_hi, li, cvt_ss; };
__global__ void __launch_bounds__(NWAVES * 64, 2) mk_fwd(Args args) {
    extern __shared__ __attribute__((aligned(16))) unsigned char lds[];
    Frame F;
    F.lds = (LAS unsigned char*)lds;
    F.MISC = (volatile LAS unsigned*)(F.lds + MISC_OFF);
    F.tid = threadIdx.x; F.lane = F.tid & 63; F.wave = __builtin_amdgcn_readfirstlane(F.tid >> 6);
    F.G = gridDim.x; { const int bx = blockIdx.x; F.vcu = (F.G % 8 == 0) ? (bx % 8) * (F.G / 8) + bx / 8 : bx; }
    unsigned char* ws = args.ws; F.ws = ws; F.out = args.out;
#pragma unroll
    for (int i = 0; i < 18; ++i) F.in[i] = args.in[i];
    F.ctl = (gu32*)(ws + WS_CTL);
    for (int u = F.tid; u < (LDS_BYTES - LDSCTL_OFF) / 4; u += NWAVES * 64) ((LAS unsigned*)(F.lds + LDSCTL_OFF))[u] = 0u;
    __syncthreads();
    XcdBarrier bar = xcd_barrier_post((unsigned*)(F.ctl + CW_BAR) + args.li * XCD_BAR_WORDS, F.MISC + 8);
    const int lo = args.ph_lo, hi = args.ph_hi;
#define IN(k) (lo <= (k) && (k) < hi)
#define SEAM(k) do { if (IN(k) && IN((k) + 1)) xcd_barrier(bar); } while (0)
    float* ss = (float*)(ws + WS_SS);
    bf16* XB = (bf16*)(ws + WS_XB); bf16* PROJ = (bf16*)(ws + WS_PROJ); bf16* HB = (bf16*)(ws + WS_H); bf16* OC = (bf16*)(ws + WS_OC); bf16* OB = (bf16*)(ws + WS_O);
    if (IN(0)) { p0_prologue(F); SEAM(0); }
#define LAYER_BODY(l) do { \
        const int pb = 1 + 7 * l; \
        if (IN(pb + 0)) { const int N = l ? NI1 : NI0; \
            pg8::Gemm g{XB, (const bf16*)(ws + (l ? WS_WIN1 : WS_WIN0)), M, N, D}; pg8::StaticOrder S; S.init(M, N, F.G, (int)blockIdx.x); \
            pg8::EpiProj E{PROJ, N, ss + (size_t)(2 * l) * M}; \
            pg8::gemm_phase<pg8::EpiProj, pg8::StaticOrder, PG8_ALIGN, PG8_SP2>(F.lds + RING_OFF, g, S, E); SEAM(pb + 0); } \
        if (IN(pb + 1)) { if (l == 0) rope_phase<0>(F); else rope_phase<1>(F); SEAM(pb + 1); } \
        if (IN(pb + 2)) { if (l == 0) attention_phase<0>(F, (char*)lds + RING_OFF); else attention_phase<1>(F, (char*)lds + RING_OFF); if (IN(pb + 4)) xcd_barrier(bar); } \
          \
        if (IN(pb + 4)) { pg8::Gemm g{l ? OC : OB, (const bf16*)(ws + (l ? WS_WO1 : WS_WO0)), M, D, D}; pg8::StaticOrder S; S.init(M, D, F.G, (int)blockIdx.x); \
            pg8::EpiResid E{l ? (const float*)F.out : F.in[0], F.out, XB, ss + (size_t)(2 * l + 1) * M}; \
            pg8::gemm_phase<pg8::EpiResid, pg8::StaticOrder, PG8_ALIGN, PG8_SP2>(F.lds + RING_OFF, g, S, E); SEAM(pb + 4); } \
        if (IN(pb + 5)) { pg8::Gemm g{XB, (const bf16*)(ws + (l ? WS_WGU1 : WS_WGU0)), M, 2 * FF, D}; pg8::StaticOrder S; S.init(M, 2 * FF, F.G, (int)blockIdx.x); \
            pg8::EpiSwiGLU E{HB, FF, ss + (size_t)(2 * l + 1) * M}; \
            pg8::gemm_phase<pg8::EpiSwiGLU, pg8::StaticOrder, PG8_ALIGN, PG8_SP2>(F.lds + RING_OFF, g, S, E); SEAM(pb + 5); } \
        if (IN(pb + 6)) { pg8::Gemm g{HB, (const bf16*)(ws + (l ? WS_WD1 : WS_WD0)), M, D, FF}; pg8::StaticOrder S; S.init(M, D, F.G, (int)blockIdx.x); \
            pg8::EpiResid E{F.out, F.out, XB, ss + (size_t)(2 * l + 2) * M}; \
            pg8::gemm_phase<pg8::EpiResid, pg8::StaticOrder, PG8_ALIGN, PG8_SP2>(F.lds + RING_OFF, g, S, E); SEAM(pb + 6); } \
    } while (0)
    LAYER_BODY(0);
    LAYER_BODY(1);
#undef LAYER_BODY
    if (IN(15)) final_norm_phase(F);
    if (IN(16)) cvt_rows(F, F.out, XB, ss + (size_t)args.cvt_ss * M);
#undef IN
#undef SEAM
}

static int g_grid = 0;
static int g_li = 0;
static void fast_seg(void* const* d_in, void* d_out, void* d_ws, hipStream_t stream, int lo, int hi, int cvt_ss = 0) {
    Args a{};
    for (int i = 0; i < 18; ++i) a.in[i] = (const float*)d_in[i];
    a.out = (float*)d_out; a.ws = (unsigned char*)d_ws; a.ph_lo = lo; a.ph_hi = hi; a.li = g_li++; a.cvt_ss = cvt_ss;
    hipLaunchKernelGGL(mk_fwd, dim3(g_grid), dim3(NWAVES * 64), LDS_BYTES, stream, a);
}
extern "C" void kernel_launch(void* const* d_in, const int* in_sizes, int n_in, void* d_out, int out_size, void* d_ws, size_t ws_size, hipStream_t stream) {
    if (g_grid == 0) {
        if (n_in != 18 || in_sizes[0] != M * D || out_size != M * D || ws_size < WS_END) { fprintf(stderr, "kernel_launch: unexpected shapes (n_in %d, ws %zu)\n", n_in, ws_size); g_grid = -1; return; }
        int dev = 0, cus = 0, per_cu = 0;
        if (hipGetDevice(&dev) != hipSuccess || hipDeviceGetAttribute(&cus, hipDeviceAttributeMultiprocessorCount, dev) != hipSuccess) { g_grid = -1; return; }
        if (hipFuncSetAttribute((const void*)mk_fwd, hipFuncAttributeMaxDynamicSharedMemorySize, LDS_BYTES) != hipSuccess) { fprintf(stderr, "kernel_launch: hipFuncSetAttribute failed\n"); g_grid = -1; return; }
        if (hipOccupancyMaxActiveBlocksPerMultiprocessor(&per_cu, (const void*)mk_fwd, NWAVES * 64, LDS_BYTES) != hipSuccess || per_cu < 1) fprintf(stderr, "kernel_launch: occupancy query reports %d\n", per_cu);
        (void)hipGetLastError();
        g_grid = cus;
    }
    if (g_grid < 0) return;
    g_li = 0;
    hipMemsetAsync((char*)d_ws + WS_CTL, 0, CTL_ZERO_BYTES, stream);
    fast_seg(d_in, d_out, d_ws, stream, 0, 16);

}
```

```cpp
#include <hip/hip_runtime.h>
#include <cstdio>
#include <cstdint>
namespace pg8 {
#define PG8_LAS __attribute__((address_space(3)))
typedef unsigned short bf16_t;
typedef short bf16x8 __attribute__((ext_vector_type(8)));
typedef float f32x4 __attribute__((ext_vector_type(4)));
typedef unsigned u32x4 __attribute__((ext_vector_type(4)));
constexpr int BM = 256, BK = 64, HALF = 128, HTB = HALF * BK * 2  , STAGE_BYTES = 8 * HTB, NXCD = 8, WGM = 8;

__host__ __device__ __forceinline__ int lds_byte(int r, int c) { const int st = (r >> 4) * 2 + (c >> 5), rr = r & 15, cc = c & 31, ob = rr * 64 + cc * 2; return st * 1024 + (ob ^ (((ob >> 9) & 1) << 5)); }
__host__ __device__ __forceinline__ void stage_rc(int b, int& R, int& C) { const int st = b / 1024, sb = b % 1024, swz = sb ^ (((sb >> 9) & 1) << 5); R = (st >> 1) * 16 + swz / 64; C = (st & 1) * 32 + (swz % 64) / 2; }
__host__ __device__ __forceinline__ int perm32(int rho) { const int n = rho >> 4, i = rho & 15; return 8 * (i >> 2) + 4 * n + (i & 3); }

struct Unit { int pm, pn; };
struct Gemm { const bf16_t* A; const bf16_t* Bt; int M, N, K; };

struct StaticOrder {
    int nM, nN, nwg, G, c;
    __host__ __device__ void init(int M, int N, int G_, int c_) { nM = M / BM; nN = N / BM; nwg = nM * nN; G = G_; c = c_; }
    __host__ __device__ bool next(int i, Unit& u) const {
        const long L = (long)i * G + c; if (L >= nwg) return false;
        int wgid = (int)L; { const int q = nwg / NXCD, r = nwg % NXCD, xcd = wgid % NXCD, off = wgid / NXCD; wgid = (xcd < r ? xcd * (q + 1) : r * (q + 1) + (xcd - r) * q) + off; }
        const int nig = WGM * nN, gid = wgid / nig, fm = gid * WGM, gsz = (nM - fm) < WGM ? (nM - fm) : WGM;
        u.pm = fm + ((wgid % nig) % gsz); u.pn = (wgid % nig) / gsz; return true;
    }
    __device__ __forceinline__ void a_ready(const Unit&) const {}
    __device__ __forceinline__ void done(const Unit&) const {}
};

__device__ __forceinline__ unsigned cvt_pk_bf16(float lo, float hi) { unsigned r; asm volatile("v_cvt_pk_bf16_f32 %0, %1, %2" : "=v"(r) : "v"(lo), "v"(hi)); return r; }
typedef float f32x2 __attribute__((ext_vector_type(2)));
constexpr float RMS_EPS = 1e-6f;
struct EpiProj {
    static constexpr bool PERM = true, AFTER_DRAIN = false;
    bf16_t* O; int ldc; const float* ss;
    __device__ __forceinline__ void operator()(const f32x4 (&acc)[2][2][4][2], const Unit& u, int wr, int wc, int fr, int fq) const {
        const int row0 = u.pm * BM + wr * 64 + fr, col0 = u.pn * BM + wc * 32 + 8 * fq;
#pragma unroll
        for (int ai = 0; ai < 2; ++ai)
#pragma unroll
            for (int m = 0; m < 4; ++m) { const int row = row0 + ai * HALF + m * 16; const float r = rsqrtf(ss[row] * (1.0f / 1024.0f) + RMS_EPS);
                bf16_t* rowp = O + (size_t)row * ldc + col0;
#pragma unroll
                for (int bj = 0; bj < 2; ++bj) { const f32x4 v0 = acc[ai][bj][m][0] * r, v1 = acc[ai][bj][m][1] * r; u32x4 w;
                    w.x = cvt_pk_bf16(v0[0], v0[1]); w.y = cvt_pk_bf16(v0[2], v0[3]); w.z = cvt_pk_bf16(v1[0], v1[1]); w.w = cvt_pk_bf16(v1[2], v1[3]);
                    *(u32x4*)(rowp + bj * HALF) = w; } }
    }
};
__device__ __forceinline__ float silu_mul(float g, float u) { return g * __builtin_amdgcn_rcpf(1.0f + __expf(-g)) * u; }
struct EpiSwiGLU {
    static constexpr bool PERM = true, AFTER_DRAIN = false;
    bf16_t* H; int ldc; const float* ss;
    __device__ __forceinline__ void operator()(const f32x4 (&acc)[2][2][4][2], const Unit& u, int wr, int wc, int fr, int fq) const {
        const int row0 = u.pm * BM + wr * 64 + fr, col0 = u.pn * HALF + wc * 32 + 8 * fq;
#pragma unroll
        for (int ai = 0; ai < 2; ++ai)
#pragma unroll
            for (int m = 0; m < 4; ++m) { const int row = row0 + ai * HALF + m * 16; const float r = rsqrtf(ss[row] * (1.0f / 1024.0f) + RMS_EPS);
                const f32x4 g0 = acc[ai][0][m][0] * r, g1 = acc[ai][0][m][1] * r, u0 = acc[ai][1][m][0] * r, u1 = acc[ai][1][m][1] * r; u32x4 w;
                w.x = cvt_pk_bf16(silu_mul(g0[0], u0[0]), silu_mul(g0[1], u0[1])); w.y = cvt_pk_bf16(silu_mul(g0[2], u0[2]), silu_mul(g0[3], u0[3]));
                w.z = cvt_pk_bf16(silu_mul(g1[0], u1[0]), silu_mul(g1[1], u1[1])); w.w = cvt_pk_bf16(silu_mul(g1[2], u1[2]), silu_mul(g1[3], u1[3]));
                *(u32x4*)(H + (size_t)row * ldc + col0) = w; }
    }
};
struct EpiResid {
    static constexpr bool PERM = true, AFTER_DRAIN = false;
    const float* base; float* out; bf16_t* xb; float* ssn;
    __device__ __forceinline__ void operator()(const f32x4 (&acc)[2][2][4][2], const Unit& u, int wr, int wc, int fr, int fq) const {
        const int row0 = u.pm * BM + wr * 64 + fr, col0 = u.pn * BM + wc * 32 + 8 * fq;
#pragma unroll
        for (int ai = 0; ai < 2; ++ai)
#pragma unroll
            for (int m = 0; m < 4; ++m) { const int row = row0 + ai * HALF + m * 16; const size_t off = (size_t)row * 1024 + col0; float q = 0.f;
#pragma unroll
                for (int bj = 0; bj < 2; ++bj) { const f32x4 b0 = *(const f32x4*)(base + off + bj * HALF), b1 = *(const f32x4*)(base + off + bj * HALF + 4);
                    const f32x4 x0 = b0 + acc[ai][bj][m][0], x1 = b1 + acc[ai][bj][m][1];
                    *(f32x4*)(out + off + bj * HALF) = x0; *(f32x4*)(out + off + bj * HALF + 4) = x1;
                    q += (x0[0] * x0[0] + x0[1] * x0[1]) + (x0[2] * x0[2] + x0[3] * x0[3]) + (x1[0] * x1[0] + x1[1] * x1[1]) + (x1[2] * x1[2] + x1[3] * x1[3]);
                    u32x4 w; w.x = cvt_pk_bf16(x0[0], x0[1]); w.y = cvt_pk_bf16(x0[2], x0[3]); w.z = cvt_pk_bf16(x1[0], x1[1]); w.w = cvt_pk_bf16(x1[2], x1[3]);
                    *(u32x4*)(xb + off + bj * HALF) = w; }
                q += __shfl_xor(q, 16); q += __shfl_xor(q, 32);
                if (fq == 0) __hip_atomic_fetch_add(ssn + row, q, __ATOMIC_RELAXED, __HIP_MEMORY_SCOPE_AGENT);
                asm volatile("" ::: "memory"); }
    }
};
template <int LAYER> struct EpiProjRope {
    static constexpr bool PERM = true, AFTER_DRAIN = false;
    bf16_t* O; int ldc; const float* ss; const float* tab; const float* qn; const float* kn; float qscale;
    __device__ __forceinline__ void operator()(const f32x4 (&acc)[2][2][4][2], const Unit& u, int wr, int wc, int fr, int fq) const {
        const int gh = 4 * u.pn + wc;
        int mode; float scale = 1.f;
        if (LAYER == 0) { mode = gh < 8 ? 2 : gh < 10 ? 3 : gh < 12 ? 0 : gh < 28 ? 1 : 0; if (gh < 8 || (gh >= 12 && gh < 20)) scale = qscale; }
        else { mode = gh < 32 ? 1 : 0; if (gh < 16) scale = qscale; }
        const int row0 = u.pm * BM + wr * 64 + fr, colb = gh * 64 + 8 * fq;
        const float* ct = tab + (mode == 1 ? 0 : 2 * 8192 * 32) + 8 * fq; const float* st = ct + 8192 * 32;
        f32x4 g0 = (f32x4){1.f, 1.f, 1.f, 1.f}, g1 = g0, g2 = g0, g3 = g0;
        if (mode >= 2) { const float* gp = (mode == 2 ? qn : kn) + 8 * fq; g0 = *(const f32x4*)gp; g1 = *(const f32x4*)(gp + 4); g2 = *(const f32x4*)(gp + 32); g3 = *(const f32x4*)(gp + 36); }
#pragma unroll
        for (int ai = 0; ai < 2; ++ai)
#pragma unroll
            for (int m = 0; m < 4; ++m) { const int row = row0 + ai * HALF + m * 16; const float r = rsqrtf(ss[row] * (1.0f / 1024.0f) + RMS_EPS); const int t = row & 8191;
                f32x4 lo0 = acc[ai][0][m][0] * r, lo1 = acc[ai][0][m][1] * r, hi0 = acc[ai][1][m][0] * r, hi1 = acc[ai][1][m][1] * r;
                if (mode >= 2) { float q = (lo0[0] * lo0[0] + lo0[1] * lo0[1]) + (lo0[2] * lo0[2] + lo0[3] * lo0[3]) + (lo1[0] * lo1[0] + lo1[1] * lo1[1]) + (lo1[2] * lo1[2] + lo1[3] * lo1[3])
                                         + (hi0[0] * hi0[0] + hi0[1] * hi0[1]) + (hi0[2] * hi0[2] + hi0[3] * hi0[3]) + (hi1[0] * hi1[0] + hi1[1] * hi1[1]) + (hi1[2] * hi1[2] + hi1[3] * hi1[3]);
                    q += __shfl_xor(q, 16); q += __shfl_xor(q, 32);
                    const float rn = rsqrtf(q * (1.0f / 64.0f) + RMS_EPS);
                    lo0 = lo0 * rn * g0; lo1 = lo1 * rn * g1; hi0 = hi0 * rn * g2; hi1 = hi1 * rn * g3; }
                if (mode) { const f32x4 c0 = *(const f32x4*)(ct + t * 32), c1 = *(const f32x4*)(ct + t * 32 + 4), s0 = *(const f32x4*)(st + t * 32), s1 = *(const f32x4*)(st + t * 32 + 4);
                    const f32x4 a0 = (lo0 * c0 - hi0 * s0) * scale, b0 = (lo0 * s0 + hi0 * c0) * scale, a1 = (lo1 * c1 - hi1 * s1) * scale, b1 = (lo1 * s1 + hi1 * c1) * scale;
                    lo0 = a0; hi0 = b0; lo1 = a1; hi1 = b1; }
                bf16_t* rowp = O + (size_t)row * ldc + colb; u32x4 w;
                w.x = cvt_pk_bf16(lo0[0], lo0[1]); w.y = cvt_pk_bf16(lo0[2], lo0[3]); w.z = cvt_pk_bf16(lo1[0], lo1[1]); w.w = cvt_pk_bf16(lo1[2], lo1[3]); *(u32x4*)rowp = w;
                w.x = cvt_pk_bf16(hi0[0], hi0[1]); w.y = cvt_pk_bf16(hi0[2], hi0[3]); w.z = cvt_pk_bf16(hi1[0], hi1[1]); w.w = cvt_pk_bf16(hi1[2], hi1[3]); *(u32x4*)(rowp + 32) = w;
                asm volatile("" ::: "memory"); }
    }
};

template <class Epi, class Sched, bool ALIGN_EPI = false, bool SP2 = false>
__device__ __forceinline__ void gemm_phase(PG8_LAS unsigned char* lds, const Gemm g, const Sched& S, const Epi& E) {
    const int tid = threadIdx.x, wid = __builtin_amdgcn_readfirstlane(tid >> 6), lane = tid & 63, wr = wid >> 2, wc = wid & 3, fr = lane & 15, fq = lane >> 4;
    const int K = g.K, nt = K / BK;
    unsigned voffA[2], voffB[2];
#pragma unroll
    for (int i = 0; i < 2; ++i) { int R, C; stage_rc(tid * 16 + i * 8192, R, C); const int Rb = Epi::PERM ? ((R & ~31) + perm32(R & 31)) : R;
        voffA[i] = (unsigned)(R * K + C) * 2u; voffB[i] = (unsigned)(Rb * K + C) * 2u; }
    const size_t kstep = (size_t)(BK * 2);
    const size_t hstep = (size_t)HALF * K * 2;
    const size_t tstep = 2 * hstep;
    const unsigned ldsw = (unsigned)wid * 1024u;
    const int aoff = lds_byte(wr * 64 + fr, fq * 8), boff = lds_byte(wc * 32 + fr, fq * 8);
#define PG8_SA(b, h) (((b) * 2 + (h)) * HTB)
#define PG8_SB(b, h) ((4 + (b) * 2 + (h)) * HTB)
#define PG8_STAGE(bufoff, gbase, voff) do { _Pragma("unroll") for (int _i = 0; _i < 2; ++_i) \
        __builtin_amdgcn_global_load_lds((const unsigned*)((const char*)(gbase) + (voff)[_i]), (PG8_LAS unsigned*)(lds + (bufoff) + ldsw + _i * 8192), 16, 0, 0); } while (0)
#define PG8_LDA(dst, b, h) do { _Pragma("unroll") for (int m = 0; m < 4; ++m) _Pragma("unroll") for (int k = 0; k < 2; ++k) dst[m][k] = *(const PG8_LAS bf16x8*)(lds + PG8_SA(b, h) + aoff + m * 2048 + k * 1024); } while (0)
#define PG8_LDB(dst, b, h) do { _Pragma("unroll") for (int n = 0; n < 2; ++n) _Pragma("unroll") for (int k = 0; k < 2; ++k) dst[n][k] = *(const PG8_LAS bf16x8*)(lds + PG8_SB(b, h) + boff + n * 2048 + k * 1024); } while (0)
#define PG8_MMA(ai, bj, At, Bt) do { __builtin_amdgcn_s_setprio(1); _Pragma("unroll") for (int m = 0; m < 4; ++m) _Pragma("unroll") for (int n = 0; n < 2; ++n) _Pragma("unroll") for (int k = 0; k < 2; ++k) \
        acc[ai][bj][m][n] = __builtin_amdgcn_mfma_f32_16x16x32_bf16(Bt[n][k], At[m][k], acc[ai][bj][m][n], 0, 0, 0); __builtin_amdgcn_s_setprio(0); } while (0)
#define PG8_WAIT_V(n) asm volatile("s_waitcnt vmcnt(" #n ")" ::: "memory")
#define PG8_WAIT_L(n) asm volatile("s_waitcnt lgkmcnt(" #n ")" ::: "memory")
#define PG8_BAR __builtin_amdgcn_s_barrier()
#define PG8_SCHED __builtin_amdgcn_sched_barrier(0)
    Unit cur, nxt; int ui = 0;
    if (!S.next(0, cur)) return;
    f32x4 acc[2][2][4][2];
#pragma unroll
    for (int a = 0; a < 2; ++a)
#pragma unroll
        for (int b = 0; b < 2; ++b)
#pragma unroll
            for (int m = 0; m < 4; ++m)
#pragma unroll
                for (int n = 0; n < 2; ++n) acc[a][b][m][n] = (f32x4){0.f, 0.f, 0.f, 0.f};
    bf16x8 At[4][2], B0[2][2], B1[2][2];
    const char* cA = (const char*)g.A + (size_t)cur.pm * tstep; const char* cB = (const char*)g.Bt + (size_t)cur.pn * tstep;
    S.a_ready(cur);
    if constexpr (SP2) {
        PG8_STAGE(PG8_SB(0, 0), cB, voffB); PG8_STAGE(PG8_SB(0, 1), cB + hstep, voffB); PG8_STAGE(PG8_SA(0, 0), cA, voffA); PG8_STAGE(PG8_SA(0, 1), cA + hstep, voffA);
        if (wr == 1) PG8_BAR;
        PG8_WAIT_V(2); PG8_BAR;
        PG8_STAGE(PG8_SB(1, 0), cB + kstep, voffB); PG8_STAGE(PG8_SA(1, 0), cA + kstep, voffA); PG8_STAGE(PG8_SB(1, 1), cB + hstep + kstep, voffB);
        PG8_WAIT_V(6); PG8_BAR;
    } else {
        PG8_STAGE(PG8_SB(0, 0), cB, voffB); PG8_STAGE(PG8_SA(0, 0), cA, voffA); PG8_STAGE(PG8_SB(0, 1), cB + hstep, voffB); PG8_STAGE(PG8_SA(0, 1), cA + hstep, voffA);
        if (wr == 1) PG8_BAR;
        PG8_WAIT_V(4); PG8_BAR;
        PG8_STAGE(PG8_SB(1, 0), cB + kstep, voffB); PG8_STAGE(PG8_SA(1, 0), cA + kstep, voffA); PG8_STAGE(PG8_SB(1, 1), cB + hstep + kstep, voffB);
        PG8_WAIT_V(6); PG8_BAR;
    }
    for (;;) {
        const bool has_next = S.next(ui + 1, nxt);
        const char* nA = has_next ? (const char*)g.A + (size_t)nxt.pm * tstep : cA; const char* nB = has_next ? (const char*)g.Bt + (size_t)nxt.pn * tstep : cB;
        for (int t = 0; t < nt; t += 2) {
            const bool last = (t == nt - 2);
            const char* a1 = cA + (size_t)(t + 1) * kstep;
            const char* a2 = last ? nA : cA + (size_t)(t + 2) * kstep; const char* b2 = last ? nB : cB + (size_t)(t + 2) * kstep;
            const char* a3 = a2 + kstep; const char* b3 = b2 + kstep;
            if (last && has_next) S.a_ready(nxt);
            if constexpr (SP2) {
            PG8_LDB(B0, 0, 0); PG8_LDB(B1, 0, 1); PG8_SCHED; PG8_LDA(At, 0, 0); PG8_STAGE(PG8_SA(1, 1), a1 + hstep, voffA);
            PG8_WAIT_V(8); PG8_WAIT_L(0); PG8_BAR; PG8_MMA(0, 0, At, B0); PG8_MMA(0, 1, At, B1); PG8_BAR; PG8_SCHED;
            PG8_LDA(At, 0, 1); PG8_STAGE(PG8_SB(0, 0), b2, voffB); PG8_STAGE(PG8_SB(0, 1), b2 + hstep, voffB); PG8_STAGE(PG8_SA(0, 0), a2, voffA);
            PG8_WAIT_V(8); PG8_WAIT_L(0); PG8_BAR; PG8_MMA(1, 0, At, B0); PG8_MMA(1, 1, At, B1); PG8_BAR; PG8_SCHED;
            PG8_LDB(B0, 1, 0); PG8_LDB(B1, 1, 1); PG8_SCHED; PG8_LDA(At, 1, 0); PG8_STAGE(PG8_SA(0, 1), a2 + hstep, voffA);
            PG8_WAIT_V(8); PG8_WAIT_L(0); PG8_BAR; PG8_MMA(0, 0, At, B0); PG8_MMA(0, 1, At, B1); PG8_BAR; PG8_SCHED;
            PG8_LDA(At, 1, 1); PG8_STAGE(PG8_SB(1, 0), b3, voffB); PG8_STAGE(PG8_SB(1, 1), b3 + hstep, voffB); PG8_STAGE(PG8_SA(1, 0), a3, voffA);
            PG8_WAIT_V(8); PG8_WAIT_L(0); PG8_BAR; PG8_MMA(1, 0, At, B0); PG8_MMA(1, 1, At, B1); PG8_BAR; PG8_SCHED;
            } else {
            PG8_LDB(B0, 0, 0); PG8_SCHED; PG8_LDA(At, 0, 0); PG8_STAGE(PG8_SA(1, 1), a1 + hstep, voffA);
            PG8_WAIT_L(8); PG8_BAR; PG8_WAIT_L(0); PG8_MMA(0, 0, At, B0); PG8_BAR; PG8_SCHED;
            PG8_LDB(B1, 0, 1); PG8_STAGE(PG8_SB(0, 0), b2, voffB);
            PG8_BAR; PG8_WAIT_L(0); PG8_MMA(0, 1, At, B1); PG8_BAR;
            PG8_LDA(At, 0, 1); PG8_STAGE(PG8_SA(0, 0), a2, voffA);
            PG8_BAR; PG8_WAIT_L(0); PG8_MMA(1, 0, At, B0); PG8_BAR; PG8_SCHED;
            PG8_STAGE(PG8_SB(0, 1), b2 + hstep, voffB);
            PG8_WAIT_V(6); PG8_BAR; PG8_MMA(1, 1, At, B1); PG8_BAR;
            PG8_LDB(B0, 1, 0); PG8_SCHED; PG8_LDA(At, 1, 0); PG8_STAGE(PG8_SA(0, 1), a2 + hstep, voffA);
            PG8_WAIT_L(8); PG8_BAR; PG8_WAIT_L(0); PG8_MMA(0, 0, At, B0); PG8_BAR; PG8_SCHED;
            PG8_LDB(B1, 1, 1); PG8_STAGE(PG8_SB(1, 0), b3, voffB);
            PG8_BAR; PG8_WAIT_L(0); PG8_MMA(0, 1, At, B1); PG8_BAR;
            PG8_LDA(At, 1, 1); PG8_STAGE(PG8_SA(1, 0), a3, voffA);
            PG8_BAR; PG8_WAIT_L(0); PG8_MMA(1, 0, At, B0); PG8_BAR; PG8_SCHED;
            PG8_STAGE(PG8_SB(1, 1), b3 + hstep, voffB);
            PG8_WAIT_V(6); PG8_BAR; PG8_MMA(1, 1, At, B1); PG8_BAR;
            }
        }
        if constexpr (ALIGN_EPI) { if (wr == 0) PG8_BAR; }
        if constexpr (!Epi::AFTER_DRAIN) { E(acc, cur, wr, wc, fr, fq); S.done(cur); }
        if (!has_next) break;
#pragma unroll
        for (int a = 0; a < 2; ++a)
#pragma unroll
            for (int b = 0; b < 2; ++b)
#pragma unroll
                for (int m = 0; m < 4; ++m)
#pragma unroll
                    for (int n = 0; n < 2; ++n) acc[a][b][m][n] = (f32x4){0.f, 0.f, 0.f, 0.f};
        cur = nxt; cA = nA; cB = nB; ++ui;
        if constexpr (ALIGN_EPI) { if (wr == 1) PG8_BAR; }
    }
    PG8_WAIT_V(0);
    if constexpr (!ALIGN_EPI) { if (wr == 0) PG8_BAR; }
    PG8_BAR;
    if constexpr (Epi::AFTER_DRAIN) { E.fused(acc, cur, wr, wc, fr, fq, lds, wid, lane); S.done(cur); }
#undef PG8_SA
#undef PG8_SB
#undef PG8_STAGE
#undef PG8_LDA
#undef PG8_LDB
#undef PG8_MMA
#undef PG8_WAIT_V
#undef PG8_WAIT_L
#undef PG8_BAR
#undef PG8_SCHED
}
}

#ifndef PG8_SP2
#define PG8_SP2 true
#endif
#ifndef PG8_ALIGN
#define PG8_ALIGN true
#endif
#include <hip/hip_bf16.h>
#include <cmath>
namespace attn_body {
using bf16=__hip_bfloat16;
using bf16x8=__attribute__((ext_vector_type(8)))short;
using s16x4=__attribute__((ext_vector_type(4)))short;
using f32x16=__attribute__((ext_vector_type(16)))float;
using u32x4=__attribute__((ext_vector_type(4)))unsigned;
constexpr int SEQ=8192,D=64;
constexpr int NW=8,QBLK=32,QB=QBLK*NW,KVBLK=64,NQB=SEQ/QB;
constexpr int ATTN_UNIT_ROWS=QB;
__device__ __forceinline__ int crow(int r,int hi){return (r&3)+8*(r>>2)+4*hi;}
#define SBAR() __builtin_amdgcn_sched_barrier(0)
__device__ __forceinline__ void cmask(f32x16&p0,f32x16&p1,int jb,int qrel,int hi){
  const float NEG=-INFINITY; int kb=64*jb+4*hi;
  #pragma unroll
  for(int r=0;r<16;++r){int kv=kb+(r&3)+8*(r>>2); if(kv>qrel)p0[r]=NEG; if(kv+32>qrel)p1[r]=NEG;}
}

typedef __attribute__((address_space(3))) const float* lds_fptr;
__device__ __forceinline__ void dmask(f32x16&p0,f32x16&p1,lds_fptr tb){
  #pragma unroll
  for(int r=0;r<16;++r){p0[r]+=tb[(r&3)+8*(r>>2)]; p1[r]+=tb[32+(r&3)+8*(r>>2)];}
}
constexpr int NSLOT=3, SLOTB=8192;
constexpr int LDS_K=0, LDS_V=NSLOT*SLOTB, LDS_WS=2*NSLOT*SLOTB, LDS_OST=LDS_WS+NW*64*4, LDS_BYTES=LDS_OST+NW*4096;
constexpr float C2=0.125f*1.4426950408889634f;
__device__ __forceinline__ void glds16(const void*gsrc,unsigned lds_dst){unsigned keep;
  asm volatile("s_mov_b32 %0, m0\n\ts_mov_b32 m0, %2\n\ts_nop 0\n\tglobal_load_lds_dwordx4 %1, off\n\ts_mov_b32 m0, %0":"=&s"(keep):"v"(gsrc),"s"(lds_dst):"memory");}
__device__ __forceinline__ float max3f(float a,float b,float c){float r;asm("v_max3_f32 %0, %1, %2, %3":"=v"(r):"v"(a),"v"(b),"v"(c));return r;}
__device__ __forceinline__ float max2f(float a,float b){float r;asm("v_max_f32_e32 %0, %1, %2":"=v"(r):"v"(a),"v"(b));return r;}
__device__ __forceinline__ float fadd_s(float a,float b){float r;asm("v_add_f32_e32 %0, %1, %2":"=v"(r):"v"(a),"v"(b));return r;}
__device__ __forceinline__ float fsub_s(float a,float b){float r;asm("v_sub_f32_e32 %0, %1, %2":"=v"(r):"v"(a),"v"(b));return r;}
typedef float f32x2_t __attribute__((ext_vector_type(2))); typedef __bf16 bf16x2_t __attribute__((ext_vector_type(2)));
__device__ __forceinline__ unsigned cvtpk_s(float lo,float hi){f32x2_t v={lo,hi};bf16x2_t b=__builtin_convertvector(v,bf16x2_t);return __builtin_bit_cast(unsigned,b);}
#define WAIT_BAR(N) asm volatile("s_waitcnt vmcnt(" #N ") lgkmcnt(0)\n\ts_barrier":::"memory")

__device__ __forceinline__ void qkt(f32x16&p0,f32x16&p1,const char*Kslot,const bf16x8*qr,const f32x16&negm,int r32,int hi){
  const char*kb=Kslot+hi*1024+r32*16;
  #pragma unroll
  for(int d0=0;d0<4;++d0){
    const bf16x8 b0=*reinterpret_cast<const bf16x8*>(kb+d0*2048);
    const bf16x8 b1=*reinterpret_cast<const bf16x8*>(kb+d0*2048+512);
    if(d0==0){p0=__builtin_amdgcn_mfma_f32_32x32x16_bf16(b0,qr[0],negm,0,0,0);p1=__builtin_amdgcn_mfma_f32_32x32x16_bf16(b1,qr[0],negm,0,0,0);}
    else{p0=__builtin_amdgcn_mfma_f32_32x32x16_bf16(b0,qr[d0],p0,0,0,0);p1=__builtin_amdgcn_mfma_f32_32x32x16_bf16(b1,qr[d0],p1,0,0,0);}}
}
typedef __attribute__((address_space(3))) const char* lds_cptr;
typedef short v4i16_t __attribute__((ext_vector_type(4)));
__device__ __forceinline__ void kload8(bf16x8*kf,lds_cptr kp){
  kf[0]=*(const __attribute__((address_space(3))) bf16x8*)(kp);      kf[1]=*(const __attribute__((address_space(3))) bf16x8*)(kp+512);
  kf[2]=*(const __attribute__((address_space(3))) bf16x8*)(kp+2048); kf[3]=*(const __attribute__((address_space(3))) bf16x8*)(kp+2560);
  kf[4]=*(const __attribute__((address_space(3))) bf16x8*)(kp+4096); kf[5]=*(const __attribute__((address_space(3))) bf16x8*)(kp+4608);
  kf[6]=*(const __attribute__((address_space(3))) bf16x8*)(kp+6144); kf[7]=*(const __attribute__((address_space(3))) bf16x8*)(kp+6656);
}
__device__ __forceinline__ void kload2(bf16x8*kf,lds_cptr kp,int j){ kf[2*j]=*(const __attribute__((address_space(3))) bf16x8*)(kp+j*2048); kf[2*j+1]=*(const __attribute__((address_space(3))) bf16x8*)(kp+j*2048+512); }
__device__ __forceinline__ s16x4 vtr(lds_cptr p){ return __builtin_bit_cast(s16x4,__builtin_amdgcn_ds_read_tr16_b64_v4i16((__attribute__((address_space(3))) v4i16_t*)p)); }
__device__ __forceinline__ float rowmax(const f32x16&p0,const f32x16&p1){
  float a=max3f(p0[0],p0[1],p1[0]),b=max3f(p0[2],p0[3],p1[1]);a=max3f(a,p1[2],p1[3]);
  #pragma unroll
  for(int r=4;r<16;r+=4){a=max3f(a,p0[r],p0[r+1]);b=max3f(b,p0[r+2],p0[r+3]);a=max3f(a,p1[r],p1[r+1]);b=max3f(b,p1[r+2],p1[r+3]);}
  const float m=max2f(a,b);
  auto rr=__builtin_amdgcn_permlane32_swap(__float_as_uint(m),__float_as_uint(m),false,false);
  return max2f(__uint_as_float(rr[0]),__uint_as_float(rr[1]));
}
__device__ __forceinline__ void pv(f32x16*o,int vb,bf16x8 pa0,bf16x8 pa1,bf16x8 pa2,bf16x8 pa3){
  #pragma unroll
  for(int d0=0;d0<2;++d0){s16x4 lo[4],hi[4];
    #pragma unroll
    for(int ks=0;ks<4;++ks){
      asm volatile("ds_read_b64_tr_b16 %0,%1 offset:%c2":"=&v"(lo[ks]):"v"(vb),"i"(d0*4096+ks*1024):"memory");
      asm volatile("ds_read_b64_tr_b16 %0,%1 offset:%c2":"=&v"(hi[ks]):"v"(vb),"i"(d0*4096+ks*1024+512):"memory");}
    asm volatile("s_waitcnt lgkmcnt(0)":::"memory");SBAR();
    #define PK(k) (bf16x8){lo[k][0],lo[k][1],lo[k][2],lo[k][3],hi[k][0],hi[k][1],hi[k][2],hi[k][3]}
    o[d0]=__builtin_amdgcn_mfma_f32_32x32x16_bf16(pa0,PK(0),o[d0],0,0,0);
    o[d0]=__builtin_amdgcn_mfma_f32_32x32x16_bf16(pa1,PK(1),o[d0],0,0,0);
    o[d0]=__builtin_amdgcn_mfma_f32_32x32x16_bf16(pa2,PK(2),o[d0],0,0,0);
    o[d0]=__builtin_amdgcn_mfma_f32_32x32x16_bf16(pa3,PK(3),o[d0],0,0,0);
    #undef PK
  }
}

#ifndef ATTN_STORE16
#define ATTN_STORE16(p,v) (*(u32x4*)(p)=(v))
#endif
constexpr int DTBL_OFF=86016, DTBL_N=2560;
template<int THRL,int MODE> __device__ __forceinline__ void attn_unit(const bf16*Qb,const bf16*__restrict__ Kt0,const bf16*__restrict__ Vt0,bf16*Ob,const int pin,const int pout,const int NT,const int kvbase,char*shm){
  const int tid=threadIdx.x,lane=tid&63,r32=lane&31,hi=lane>>5; const int wid=__builtin_amdgcn_readfirstlane(tid>>6);
  const bf16*Qw=Qb+(long)(wid*QBLK)*pin;
  const bf16*Kh=Kt0,*Vh=Vt0;
  const unsigned lds0=(unsigned)(uintptr_t)shm;
  float*wsf=(float*)(shm+LDS_WS)+wid*64;
  const bf16*ksrc=Kh+(long)lane*pin+wid*8;
  const bf16*vsrc=Vh+(long)(16*(wid&3)+(lane>>2))*pin+(wid>>2)*32+(lane&3)*8;
  const unsigned kdst=lds0+LDS_K+wid*1024, vdst=lds0+LDS_V+wid*1024;
  #define DMA_K(t,slot) glds16(ksrc+(long)(t)*KVBLK*pin,(unsigned)__builtin_amdgcn_readfirstlane(kdst+(slot)))
  #define DMA_V(t,slot) glds16(vsrc+(long)(t)*KVBLK*pin,(unsigned)__builtin_amdgcn_readfirstlane(vdst+(slot)))
  const int vb0=(int)(lds0+LDS_V)+((lane>>4)&1)*32+(lane&3)*8+(4*hi+((lane&15)>>2))*64;
  const char*Kbase=shm+LDS_K; bf16x8 kf[8];
  const lds_cptr shm3=(lds_cptr)shm; const lds_cptr kp0=shm3+LDS_K+hi*1024+r32*16; const lds_cptr vp0=shm3+LDS_V+((lane>>4)&1)*32+(lane&3)*8+(4*hi+((lane&15)>>2))*64;
  DMA_K(0,0);DMA_V(0,0);DMA_K(1,SLOTB);
  bf16x8 qr[4];
  #pragma unroll
  for(int d0=0;d0<4;++d0)qr[d0]=*reinterpret_cast<const bf16x8*>(&Qw[(long)r32*pin+d0*16+hi*8]);
  float mhat=0.f,l_reg=0.f;f32x16 o[2];o[0]=f32x16{};o[1]=f32x16{};f32x16 negm=f32x16{};asm volatile("":"+v"(negm));
  const int qrel=wid*QBLK+r32;
  const lds_fptr dtb=(lds_fptr)(shm3+DTBL_OFF)+(kvbase+4*hi-qrel+1280);
  #define CMASK(P0,P1,t) do{ if(MODE==1) dmask(P0,P1,dtb+64*(t)); }while(0)
  bool resc=false;
  #define START(P0,P1) do{ const float rm=rowmax(P0,P1); resc=false; \
    { const float dl=rm; mhat=fadd_s(mhat,dl); \
      _Pragma("unroll") for(int r=0;r<16;++r){P0[r]=fsub_s(P0[r],dl);P1[r]=fsub_s(P1[r],dl);} \
      _Pragma("unroll") for(int r=0;r<16;++r)negm[r]=-mhat; asm volatile("":"+v"(negm)); } \
    _Pragma("unroll") for(int r=0;r<16;++r)P0[r]=__builtin_amdgcn_exp2f(P0[r]); }while(0)
  #define RESC() do{ if(resc){ asm volatile("s_waitcnt lgkmcnt(0)":::"memory"); \
      _Pragma("unroll") for(int d_=0;d_<2;++d_) _Pragma("unroll") for(int r=0;r<16;++r)o[d_][r]*=wsf[crow(r,hi)]; } }while(0)
  f32x16 pA0,pA1,pB0,pB1;
  int sl_prev=0,sl_cur=0,sl_next=SLOTB;
  #define ROT() do{sl_prev=sl_cur;sl_cur=sl_next;sl_next=(sl_next==(NSLOT-1)*SLOTB)?0:sl_next+SLOTB;}while(0)
  DMA_K(2,2*SLOTB);
  WAIT_BAR(3);
  qkt(pA0,pA1,Kbase,qr,negm,r32,hi);asm volatile("s_nop 15\n\ts_nop 7":"+v"(pA0),"+v"(pA1));CMASK(pA0,pA1,0);
  START(pA0,pA1);
  _Pragma("unroll") for(int r=0;r<16;++r)pA1[r]=__builtin_amdgcn_exp2f(pA1[r]);
  WAIT_BAR(0);
  DMA_K(3,0);DMA_V(1,SLOTB);
  ROT();
  kload8(kf,kp0+sl_cur);
  WAIT_BAR(2);
  s16x4 vlo[8],vhi[8]; u32x4 pw0,pw1,pw2,pw3;
  #define PKW(P,B) cvtpk_s(P[B],P[B+1])
  #define PAF(k) __builtin_bit_cast(bf16x8,pw##k)
  #define VFR(i) (bf16x8){vlo[i][0],vlo[i][1],vlo[i][2],vlo[i][3],vhi[i][0],vhi[i][1],vhi[i][2],vhi[i][3]}
  #define PIN(x) asm volatile("":"+v"(x))
  #define MX3(a,b,c) __builtin_fmaxf(__builtin_fmaxf((a),(b)),(c))
  #define GAPA(MF,A0,A1,A2,A3,W0,W1,PW) do{ MF; sacc+=A0; sacc+=A1; sacc+=A2; sacc+=A3; PIN(sacc); W0; W1; PIN(PW); SBAR(); }while(0)
  #define EX(v) __builtin_amdgcn_exp2f(v)
  #define GAPB(MF,X,B) do{ MF; X[B]=EX(X[B]); X[B+1]=EX(X[B+1]); X[B+2]=EX(X[B+2]); X[B+3]=EX(X[B+3]); PIN(X); SBAR(); }while(0)
  #define VRD(i) do{ vlo[i]=vtr(vp_+(((i)>>2)*4096+((i)&3)*1024)); vhi[i]=vtr(vp_+(((i)>>2)*4096+((i)&3)*1024+512)); }while(0)
  #define KRD(G,j) do{ if(G){ kload2(kf,kp0+sl_next,j); SBAR(); } }while(0)
  #define STEP(C0,C1,P0,P1,t,GK,GV,GL) do{ SBAR(); \
    const lds_cptr vp_=vp0+sl_prev; \
    VRD(0); SBAR(); float sacc=(P0[0]+P0[1]); \
    GAPA(C0=__builtin_amdgcn_mfma_f32_32x32x16_bf16(kf[0],qr[0],negm,0,0,0), P0[2],P0[3],P0[4],P0[5],     pw0[0]=PKW(P0,0), pw0[1]=PKW(P0,2), pw0); \
    VRD(4); SBAR(); GAPA(C1=__builtin_amdgcn_mfma_f32_32x32x16_bf16(kf[1],qr[0],negm,0,0,0), P0[6],P0[7],P0[8],P0[9],     pw0[2]=PKW(P0,4), pw0[3]=PKW(P0,6), pw0); \
    VRD(1); SBAR(); GAPA(C0=__builtin_amdgcn_mfma_f32_32x32x16_bf16(kf[2],qr[1],C0,0,0,0),   P0[10],P0[11],P0[12],P0[13], pw1[0]=PKW(P0,8), pw1[1]=PKW(P0,10), pw1); \
    VRD(5); SBAR(); GAPA(C1=__builtin_amdgcn_mfma_f32_32x32x16_bf16(kf[3],qr[1],C1,0,0,0),   P0[14],P0[15],P1[0],P1[1],   pw1[2]=PKW(P0,12),pw1[3]=PKW(P0,14), pw1); \
    VRD(2); SBAR(); GAPA(C0=__builtin_amdgcn_mfma_f32_32x32x16_bf16(kf[4],qr[2],C0,0,0,0),   P1[2],P1[3],P1[4],P1[5],     pw2[0]=PKW(P1,0), pw2[1]=PKW(P1,2), pw2); \
    VRD(6); SBAR(); GAPA(C1=__builtin_amdgcn_mfma_f32_32x32x16_bf16(kf[5],qr[2],C1,0,0,0),   P1[6],P1[7],P1[8],P1[9],     pw2[2]=PKW(P1,4), pw2[3]=PKW(P1,6), pw2); \
    VRD(3); SBAR(); GAPA(C0=__builtin_amdgcn_mfma_f32_32x32x16_bf16(kf[6],qr[3],C0,0,0,0),   P1[10],P1[11],P1[12],P1[13], pw3[0]=PKW(P1,8), pw3[1]=PKW(P1,10), pw3); \
    VRD(7); SBAR(); GAPA(C1=__builtin_amdgcn_mfma_f32_32x32x16_bf16(kf[7],qr[3],C1,0,0,0),   P1[14],P1[15],0.f,0.f,       pw3[2]=PKW(P1,12),pw3[3]=PKW(P1,14), pw3); \
    l_reg+=sacc; \
    if(GK){DMA_K((t)+3,sl_cur);} if(GV){DMA_V((t)+1,sl_next);} \
    CMASK(C0,C1,t); \
    { float a=MX3(C0[0],C0[1],C1[0]),b=MX3(C0[2],C0[3],C1[1]); a=MX3(a,C1[2],C1[3]); \
      _Pragma("unroll") for(int r=4;r<16;r+=4){a=MX3(a,C0[r],C0[r+1]);b=MX3(b,C0[r+2],C0[r+3]);a=MX3(a,C1[r],C1[r+1]);b=MX3(b,C1[r+2],C1[r+3]);} \
      float rm=__builtin_fmaxf(a,b); { auto rr=__builtin_amdgcn_permlane32_swap(__float_as_uint(rm),__float_as_uint(rm),false,false); rm=__builtin_fmaxf(__uint_as_float(rr[0]),__uint_as_float(rr[1])); } \
      resc=false; \
      if(__builtin_expect(__any(rm>(float)THRL),0)){ const float dl=__builtin_fmaxf(rm,0.f); mhat+=dl; \
        _Pragma("unroll") for(int r=0;r<16;++r){C0[r]-=dl;C1[r]-=dl;} \
        _Pragma("unroll") for(int r=0;r<16;++r)negm[r]=-mhat; asm volatile("":"+v"(negm)); \
        const float f=__builtin_amdgcn_exp2f(-dl); l_reg*=f; if(hi==0)wsf[r32]=f; resc=true; } } \
    SBAR(); \
    GAPB(o[0]=__builtin_amdgcn_mfma_f32_32x32x16_bf16(PAF(0),VFR(0),o[0],0,0,0), C0,0); \
    GAPB(o[1]=__builtin_amdgcn_mfma_f32_32x32x16_bf16(PAF(0),VFR(4),o[1],0,0,0), C0,4); \
    KRD(GL,0); GAPB(o[0]=__builtin_amdgcn_mfma_f32_32x32x16_bf16(PAF(1),VFR(1),o[0],0,0,0), C0,8); \
    KRD(GL,1); GAPB(o[1]=__builtin_amdgcn_mfma_f32_32x32x16_bf16(PAF(1),VFR(5),o[1],0,0,0), C0,12); \
    KRD(GL,2); GAPB(o[0]=__builtin_amdgcn_mfma_f32_32x32x16_bf16(PAF(2),VFR(2),o[0],0,0,0), C1,0); \
    KRD(GL,3); GAPB(o[1]=__builtin_amdgcn_mfma_f32_32x32x16_bf16(PAF(2),VFR(6),o[1],0,0,0), C1,4); \
    GAPB(o[0]=__builtin_amdgcn_mfma_f32_32x32x16_bf16(PAF(3),VFR(3),o[0],0,0,0), C1,8); \
    GAPB(o[1]=__builtin_amdgcn_mfma_f32_32x32x16_bf16(PAF(3),VFR(7),o[1],0,0,0), C1,12); \
    }while(0)
  int t=1;
  if(wid>=4)__builtin_amdgcn_s_setprio(1);
  for(;t+5<NT;t+=2){
    STEP(pB0,pB1,pA0,pA1,t,true,true,true);     WAIT_BAR(2); RESC(); ROT();
    STEP(pA0,pA1,pB0,pB1,t+1,true,true,true);   WAIT_BAR(2); RESC(); ROT();
  }
  #define ENDW(tt) do{ if((tt)+3<NT){WAIT_BAR(2);} else if((tt)+2<NT){WAIT_BAR(1);} else {WAIT_BAR(0);} }while(0)
  for(;t+1<NT;t+=2){
    STEP(pB0,pB1,pA0,pA1,t,(t+3<NT),(t+1<NT),(t+1<NT));       ENDW(t);   RESC(); ROT();
    STEP(pA0,pA1,pB0,pB1,t+1,(t+4<NT),(t+2<NT),(t+2<NT));     ENDW(t+1); RESC(); ROT();
  }
  STEP(pB0,pB1,pA0,pA1,NT-1,false,false,false); RESC();
  __builtin_amdgcn_s_setprio(0);
  { float sacc=pB0[0]+pB0[1]; _Pragma("unroll") for(int r=2;r<16;++r)sacc+=pB0[r]; _Pragma("unroll") for(int r=0;r<16;++r)sacc+=pB1[r]; l_reg+=sacc;
    pw0=(u32x4){PKW(pB0,0),PKW(pB0,2),PKW(pB0,4),PKW(pB0,6)};pw1=(u32x4){PKW(pB0,8),PKW(pB0,10),PKW(pB0,12),PKW(pB0,14)};pw2=(u32x4){PKW(pB1,0),PKW(pB1,2),PKW(pB1,4),PKW(pB1,6)};pw3=(u32x4){PKW(pB1,8),PKW(pB1,10),PKW(pB1,12),PKW(pB1,14)};
    SBAR(); pv(o,vb0+sl_cur,PAF(0),PAF(1),PAF(2),PAF(3)); }
  #undef PKW
  #undef PAF
  #undef VFR
  #undef PIN
  #undef MX3
  #undef GAPA
  #undef GAPB
  #undef EX
  #undef VRD
  #undef KRD
  #undef STEP
  #undef ENDW
  {auto rr=__builtin_amdgcn_permlane32_swap(__float_as_uint(l_reg),__float_as_uint(l_reg),false,false);l_reg=__uint_as_float(rr[0])+__uint_as_float(rr[1]);}
  if(hi==0)wsf[32+r32]=l_reg;asm volatile("s_waitcnt lgkmcnt(0)":::"memory");
  float rli[16];
  #pragma unroll
  for(int r=0;r<16;++r)rli[r]=__builtin_amdgcn_rcpf(wsf[32+crow(r,hi)]);
  bf16*Ow=Ob+(long)(wid*QBLK)*pout;
  { bf16*stg=(bf16*)(shm+LDS_OST)+wid*2048;
    #pragma unroll
    for(int r=0;r<16;++r){const int orow=crow(r,hi);
      #pragma unroll
      for(int d0=0;d0<2;++d0)stg[orow*64+d0*32+r32]=__float2bfloat16(o[d0][r]*rli[r]);}
    asm volatile("s_waitcnt lgkmcnt(0)":::"memory");
    #pragma unroll
    for(int i=0;i<4;++i){const int row=i*8+(lane>>3),ch=lane&7; const u32x4 v=*(const u32x4*)(stg+row*64+ch*8); ATTN_STORE16(Ow+(long)row*pout+ch*8,v);} }
  asm volatile("s_waitcnt lgkmcnt(0)\n\ts_barrier":::"memory");
  #undef DMA_K
  #undef DMA_V
  #undef CMASK
  #undef START
  #undef RESC
  #undef ROT
}
constexpr int ATTN_LDS_BYTES=LDS_BYTES;
constexpr int U_LK=0, U_LVLO=24576, U_LVHI=49152, U_LWS=73728, U_LST=75776, U_LDS_BYTES=U_LST+NW*8192;
template<int THRL> __device__ __forceinline__ void attn_unit128(const bf16*Qb,const bf16*__restrict__ Kb,const bf16*__restrict__ Vb,bf16*Ob,const int pin,const int pout,const int NT,const float lam,const float*__restrict__ gsub,const float gscale,char*shm){
  const int tid=threadIdx.x,lane=tid&63,r32=lane&31,hi=lane>>5; const int wid=__builtin_amdgcn_readfirstlane(tid>>6);
  const unsigned lds0=(unsigned)(uintptr_t)shm;
  float*wsf=(float*)(shm+U_LWS)+wid*64;
  bf16*stg=(bf16*)(shm+U_LST)+wid*4096;
  const unsigned kdst=lds0+U_LK+wid*1024, vldst=lds0+U_LVLO+wid*1024, vhdst=lds0+U_LVHI+wid*1024;
  const int vbl=(int)(lds0+U_LVLO)+((lane>>4)&1)*32+(lane&3)*8+(4*hi+((lane&15)>>2))*64, vbh=vbl+(U_LVHI-U_LVLO);
  const bf16*vsrc=Vb+(long)(16*(wid&3)+(lane>>2))*pin+(wid>>2)*32+(lane&3)*8;
  #pragma unroll 1
  for(int sid=0;sid<2;++sid){
    const bf16*Qw=Qb+(long)(wid*QBLK)*pin+sid*64;
    const bf16*ksrc=Kb+sid*64+(long)lane*pin+wid*8;
    bf16x8 qr[4];
    #pragma unroll
    for(int d0=0;d0<4;++d0)qr[d0]=*reinterpret_cast<const bf16x8*>(&Qw[(long)r32*pin+d0*16+hi*8]);
    #define DMA3(t,slot) do{ const long off_=(long)(t)*KVBLK*pin; const unsigned so_=(unsigned)(slot)*SLOTB; \
      glds16(ksrc+off_,(unsigned)__builtin_amdgcn_readfirstlane(kdst+so_)); glds16(vsrc+off_,(unsigned)__builtin_amdgcn_readfirstlane(vldst+so_)); \
      glds16(vsrc+off_+64,(unsigned)__builtin_amdgcn_readfirstlane(vhdst+so_)); }while(0)
    DMA3(0,0); DMA3(1,1);
    float mhat=0.f,l_reg=0.f; f32x16 o[4];
    #pragma unroll
    for(int d=0;d<4;++d)o[d]=f32x16{};
    int slot=0;
    #pragma unroll 1
    for(int t=0;t<NT;++t){
      if(t+1<NT){WAIT_BAR(3);}else{WAIT_BAR(0);}
      if(t+2<NT){int s2=slot+2; if(s2>=3)s2-=3; DMA3(t+2,s2);}
      f32x16 p0,p1;
      { const f32x16 zc=f32x16{}; qkt(p0,p1,shm+U_LK+slot*SLOTB,qr,zc,r32,hi); }
      float rm;
      { float a=__builtin_fmaxf(__builtin_fmaxf(p0[0],p0[1]),p1[0]),b=__builtin_fmaxf(__builtin_fmaxf(p0[2],p0[3]),p1[1]); a=__builtin_fmaxf(__builtin_fmaxf(a,p1[2]),p1[3]);
        #pragma unroll
        for(int r=4;r<16;r+=4){a=__builtin_fmaxf(__builtin_fmaxf(a,p0[r]),p0[r+1]);b=__builtin_fmaxf(__builtin_fmaxf(b,p0[r+2]),p0[r+3]);a=__builtin_fmaxf(__builtin_fmaxf(a,p1[r]),p1[r+1]);b=__builtin_fmaxf(__builtin_fmaxf(b,p1[r+2]),p1[r+3]);}
        rm=__builtin_fmaxf(a,b); auto rr=__builtin_amdgcn_permlane32_swap(__float_as_uint(rm),__float_as_uint(rm),false,false); rm=__builtin_fmaxf(__uint_as_float(rr[0]),__uint_as_float(rr[1])); }
      const float ex_=rm-mhat;
      if(t==0 || __any(ex_>(float)THRL)){
        const float dl=(t==0)?rm:__builtin_fmaxf(ex_,0.f); mhat+=dl;
        if(t>0){ const float f=__builtin_amdgcn_exp2f(-dl); l_reg*=f; if(hi==0)wsf[r32]=f; asm volatile("s_waitcnt lgkmcnt(0)":::"memory");
          #pragma unroll
          for(int r=0;r<16;++r){const float fr_=wsf[crow(r,hi)];
            #pragma unroll
            for(int d=0;d<4;++d)o[d][r]*=fr_;} } }
      #pragma unroll
      for(int r=0;r<16;++r){p0[r]=__builtin_amdgcn_exp2f(p0[r]-mhat);p1[r]=__builtin_amdgcn_exp2f(p1[r]-mhat);}
      { float sa=0.f,sb=0.f;
        #pragma unroll
        for(int r=0;r<16;++r){sa+=p0[r];sb+=p1[r];}
        l_reg+=sa+sb; }
      u32x4 pw0,pw1,pw2,pw3;
      pw0=(u32x4){cvtpk_s(p0[0],p0[1]),cvtpk_s(p0[2],p0[3]),cvtpk_s(p0[4],p0[5]),cvtpk_s(p0[6],p0[7])};
      pw1=(u32x4){cvtpk_s(p0[8],p0[9]),cvtpk_s(p0[10],p0[11]),cvtpk_s(p0[12],p0[13]),cvtpk_s(p0[14],p0[15])};
      pw2=(u32x4){cvtpk_s(p1[0],p1[1]),cvtpk_s(p1[2],p1[3]),cvtpk_s(p1[4],p1[5]),cvtpk_s(p1[6],p1[7])};
      pw3=(u32x4){cvtpk_s(p1[8],p1[9]),cvtpk_s(p1[10],p1[11]),cvtpk_s(p1[12],p1[13]),cvtpk_s(p1[14],p1[15])};
      SBAR();
      pv(o,vbl+slot*SLOTB,__builtin_bit_cast(bf16x8,pw0),__builtin_bit_cast(bf16x8,pw1),__builtin_bit_cast(bf16x8,pw2),__builtin_bit_cast(bf16x8,pw3));
      pv(o+2,vbh+slot*SLOTB,__builtin_bit_cast(bf16x8,pw0),__builtin_bit_cast(bf16x8,pw1),__builtin_bit_cast(bf16x8,pw2),__builtin_bit_cast(bf16x8,pw3));
      slot=(slot==2)?0:slot+1;
    }
    #undef DMA3
    {auto rr=__builtin_amdgcn_permlane32_swap(__float_as_uint(l_reg),__float_as_uint(l_reg),false,false);l_reg=__uint_as_float(rr[0])+__uint_as_float(rr[1]);}
    if(hi==0)wsf[32+r32]=l_reg; asm volatile("s_waitcnt lgkmcnt(0)":::"memory");
    if(sid==0){
      #pragma unroll
      for(int r=0;r<16;++r){const int orow=crow(r,hi); const float rl=__builtin_amdgcn_rcpf(wsf[32+orow]);
        #pragma unroll
        for(int d=0;d<4;++d)stg[orow*128+d*32+r32]=__float2bfloat16(o[d][r]*rl);}
    } else {
      #pragma unroll
      for(int r=0;r<16;++r){const int orow=crow(r,hi); const float rl=__builtin_amdgcn_rcpf(wsf[32+orow]); float q=0.f;
        #pragma unroll
        for(int d=0;d<4;++d){const float v=__bfloat162float(stg[orow*128+d*32+r32])-lam*(o[d][r]*rl); o[d][r]=v; q+=v*v;}
        q+=__shfl_xor(q,1);q+=__shfl_xor(q,2);q+=__shfl_xor(q,4);q+=__shfl_xor(q,8);q+=__shfl_xor(q,16);
        const float rs=__builtin_amdgcn_rsqf(q*(1.0f/128.0f)+1e-6f);
        #pragma unroll
        for(int d=0;d<4;++d)stg[orow*128+d*32+r32]=__float2bfloat16(o[d][r]*rs*(gsub[32*d+r32]*gscale));}
      asm volatile("s_waitcnt lgkmcnt(0)":::"memory");
      bf16*Ow=Ob+(long)(wid*QBLK)*pout;
      #pragma unroll
      for(int i=0;i<8;++i){const int row=i*4+(lane>>4),ch=lane&15; const u32x4 v=*(const u32x4*)(stg+row*128+ch*8); *(u32x4*)(Ow+(long)row*pout+ch*8)=v;}
    }
    asm volatile("s_waitcnt lgkmcnt(0)\n\ts_barrier":::"memory");
  }
}
#define SWZX(v,k) __builtin_bit_cast(float,__builtin_amdgcn_ds_swizzle(__builtin_bit_cast(int,(v)),(((k)<<10)|0x1f)))
template<int THRL> __device__ __forceinline__ void attn_unit128p(const bf16*Qb,const bf16*__restrict__ Kb,const bf16*__restrict__ Vb,bf16*Ob,const int pin,const int pout,const int NT,const float lam,const float*__restrict__ gsub,const float gscale,char*shm){
  const int tid=threadIdx.x; int lane=tid&63; asm volatile("":"+v"(lane)); const int r32=lane&31,hi=lane>>5; const int wid=__builtin_amdgcn_readfirstlane(tid>>6);
  const unsigned lds0=(unsigned)(uintptr_t)shm;
  float*wsf=(float*)(shm+U_LWS)+wid*64;
  bf16*stg=(bf16*)(shm+U_LST)+wid*4096;
  const unsigned kdst=lds0+U_LK+wid*1024, vldst=lds0+U_LVLO+wid*1024, vhdst=lds0+U_LVHI+wid*1024;
  const bf16*vsrc=Vb+(long)(16*(wid&3)+(lane>>2))*pin+(wid>>2)*32+(lane&3)*8;
  const lds_cptr shm3=(lds_cptr)shm; const lds_cptr kp0=shm3+U_LK+hi*1024+r32*16;
  const lds_cptr vpl0=shm3+U_LVLO+((lane>>4)&1)*32+(lane&3)*8+(4*hi+((lane&15)>>2))*64;
  #pragma unroll 1
  for(int sid=0;sid<2;++sid){
    const bf16*Qw=Qb+(long)(wid*QBLK)*pin+sid*64;
    const bf16*ksrc=Kb+sid*64+(long)lane*pin+wid*8;
    bf16x8 qr[4];
    { int lq_=lane; asm volatile("":"+v"(lq_)); const bf16*qp_=Qw+(long)(lq_&31)*pin+(lq_>>5)*8;
      #pragma unroll
      for(int d0=0;d0<4;++d0)qr[d0]=*reinterpret_cast<const bf16x8*>(qp_+d0*16); }
    #define DMA_K(t,slot) glds16(ksrc+(long)(t)*KVBLK*pin,(unsigned)__builtin_amdgcn_readfirstlane(kdst+(slot)))
    #define DMA_V(t,slot) do{ glds16(vsrc+(long)(t)*KVBLK*pin,(unsigned)__builtin_amdgcn_readfirstlane(vldst+(slot))); glds16(vsrc+(long)(t)*KVBLK*pin+64,(unsigned)__builtin_amdgcn_readfirstlane(vhdst+(slot))); }while(0)
    DMA_K(0,0); DMA_K(1,SLOTB); DMA_V(0,0); DMA_K(2,2*SLOTB);
    float mhat=0.f,l_reg=0.f; f32x16 o[4];
    #pragma unroll
    for(int d=0;d<4;++d)o[d]=f32x16{};
    bool resc=false;
    f32x16 pA0,pA1,pB0,pB1; bf16x8 kf[8];
    int sl_prev=2*SLOTB,sl_cur=0,sl_next=SLOTB;
    #define ROT() do{const int t_=sl_prev;sl_prev=sl_cur;sl_cur=sl_next;sl_next=t_;}while(0)
    #define MX3(a,b,c) __builtin_fmaxf(__builtin_fmaxf((a),(b)),(c))
    #define ROWMAX(C0,C1,rm) do{ float a=MX3(C0[0],C0[1],C1[0]),b=MX3(C0[2],C0[3],C1[1]); a=MX3(a,C1[2],C1[3]); \
      _Pragma("unroll") for(int r=4;r<16;r+=4){a=MX3(a,C0[r],C0[r+1]);b=MX3(b,C0[r+2],C0[r+3]);a=MX3(a,C1[r],C1[r+1]);b=MX3(b,C1[r+2],C1[r+3]);} \
      rm=__builtin_fmaxf(a,b); { auto rr=__builtin_amdgcn_permlane32_swap(__float_as_uint(rm),__float_as_uint(rm),false,false); rm=__builtin_fmaxf(__uint_as_float(rr[0]),__uint_as_float(rr[1])); } }while(0)
    #define EXS(v) __builtin_amdgcn_exp2f(v)
    WAIT_BAR(3);
    kload8(kf,kp0);
    { const f32x16 zc=f32x16{};
      pA0=__builtin_amdgcn_mfma_f32_32x32x16_bf16(kf[0],qr[0],zc,0,0,0); pA1=__builtin_amdgcn_mfma_f32_32x32x16_bf16(kf[1],qr[0],zc,0,0,0);
      pA0=__builtin_amdgcn_mfma_f32_32x32x16_bf16(kf[2],qr[1],pA0,0,0,0); pA1=__builtin_amdgcn_mfma_f32_32x32x16_bf16(kf[3],qr[1],pA1,0,0,0);
      pA0=__builtin_amdgcn_mfma_f32_32x32x16_bf16(kf[4],qr[2],pA0,0,0,0); pA1=__builtin_amdgcn_mfma_f32_32x32x16_bf16(kf[5],qr[2],pA1,0,0,0);
      pA0=__builtin_amdgcn_mfma_f32_32x32x16_bf16(kf[6],qr[3],pA0,0,0,0); pA1=__builtin_amdgcn_mfma_f32_32x32x16_bf16(kf[7],qr[3],pA1,0,0,0); }
    f32x16 negm;
    { float rm; ROWMAX(pA0,pA1,rm); mhat=rm; }
    #pragma unroll
    for(int r=0;r<16;++r){pA0[r]=EXS(pA0[r]-mhat);pA1[r]=EXS(pA1[r]-mhat);}
    #pragma unroll
    for(int r=0;r<16;++r)negm[r]=-mhat;
    asm volatile("":"+v"(negm));
    kload8(kf,kp0+SLOTB);
    WAIT_BAR(3);
    DMA_K(3,0); DMA_V(1,SLOTB);
    ROT();
    s16x4 vlo[8],vhi[8],wlo[8],whi[8]; u32x4 pw0,pw1,pw2,pw3;
    #define PKW(P,B) cvtpk_s(P[B],P[B+1])
    #define PAF(k) __builtin_bit_cast(bf16x8,pw##k)
    #define VFR(i) (bf16x8){vlo[i][0],vlo[i][1],vlo[i][2],vlo[i][3],vhi[i][0],vhi[i][1],vhi[i][2],vhi[i][3]}
    #define WFR(i) (bf16x8){wlo[i][0],wlo[i][1],wlo[i][2],wlo[i][3],whi[i][0],whi[i][1],whi[i][2],whi[i][3]}
    #define PIN(x) asm volatile("":"+v"(x))
    #define GAPA(MF,A0,A1,A2,A3,W0,W1,PW) do{ MF; sacc+=A0; sacc+=A1; sacc+=A2; sacc+=A3; PIN(sacc); W0; W1; PIN(PW); SBAR(); }while(0)
    #define GAPB(MF,X,B) do{ MF; X[B]=EXS(X[B]); X[B+1]=EXS(X[B+1]); PIN(X); SBAR(); }while(0)
    #define VRD(i) do{ vlo[i]=vtr(vp_+(((i)>>2)*4096+((i)&3)*1024)); vhi[i]=vtr(vp_+(((i)>>2)*4096+((i)&3)*1024+512)); }while(0)
    #define WRD(i) do{ wlo[i]=vtr(vq_+(((i)>>2)*4096+((i)&3)*1024)); whi[i]=vtr(vq_+(((i)>>2)*4096+((i)&3)*1024+512)); }while(0)
    #define MFQ(C,k,q,CI) C=__builtin_amdgcn_mfma_f32_32x32x16_bf16(kf[k],qr[q],CI,0,0,0)
    #define MFO(d,k,VF) o[d]=__builtin_amdgcn_mfma_f32_32x32x16_bf16(PAF(k),VF,o[d],0,0,0)
    #define PHASEA(C0,C1,P0,P1) do{ SBAR(); \
      const lds_cptr vp_=vpl0+sl_prev; \
      VRD(0); SBAR(); float sacc=(P0[0]+P0[1]); \
      GAPA(MFQ(C0,0,0,negm), P0[2],P0[3],P0[4],P0[5],     pw0[0]=PKW(P0,0), pw0[1]=PKW(P0,2), pw0); \
      VRD(4); SBAR(); GAPA(MFQ(C1,1,0,negm), P0[6],P0[7],P0[8],P0[9],     pw0[2]=PKW(P0,4), pw0[3]=PKW(P0,6), pw0); \
      VRD(1); SBAR(); GAPA(MFQ(C0,2,1,C0), P0[10],P0[11],P0[12],P0[13], pw1[0]=PKW(P0,8), pw1[1]=PKW(P0,10), pw1); \
      VRD(5); SBAR(); GAPA(MFQ(C1,3,1,C1), P0[14],P0[15],P1[0],P1[1],   pw1[2]=PKW(P0,12),pw1[3]=PKW(P0,14), pw1); \
      VRD(2); SBAR(); GAPA(MFQ(C0,4,2,C0), P1[2],P1[3],P1[4],P1[5],     pw2[0]=PKW(P1,0), pw2[1]=PKW(P1,2), pw2); \
      VRD(6); SBAR(); GAPA(MFQ(C1,5,2,C1), P1[6],P1[7],P1[8],P1[9],     pw2[2]=PKW(P1,4), pw2[3]=PKW(P1,6), pw2); \
      VRD(3); SBAR(); GAPA(MFQ(C0,6,3,C0), P1[10],P1[11],P1[12],P1[13], pw3[0]=PKW(P1,8), pw3[1]=PKW(P1,10), pw3); \
      VRD(7); SBAR(); GAPA(MFQ(C1,7,3,C1), P1[14],P1[15],0.f,0.f,       pw3[2]=PKW(P1,12),pw3[3]=PKW(P1,14), pw3); \
      l_reg+=sacc; \
      { float rm; ROWMAX(C0,C1,rm); resc=false; \
        if(__builtin_expect(__any(rm>(float)THRL),0)){ const float dl=__builtin_fmaxf(rm,0.f); mhat+=dl; \
          _Pragma("unroll") for(int r=0;r<16;++r){C0[r]-=dl;C1[r]-=dl;} \
          _Pragma("unroll") for(int r=0;r<16;++r)negm[r]=-mhat; asm volatile("":"+v"(negm)); \
          const float f=__builtin_amdgcn_exp2f(-dl); l_reg*=f; if(hi==0)wsf[r32]=f; resc=true; } } \
      SBAR(); }while(0)
    #define KRD(G,j) do{ if(G){ kload2(kf,kp0+sl_next,j); SBAR(); } }while(0)
    #define PHASEB(C0,C1,GL) do{ const lds_cptr vq_=vpl0+(U_LVHI-U_LVLO)+sl_prev; \
      WRD(0); SBAR(); GAPB(MFO(0,0,VFR(0)), C0,0); \
      WRD(4); SBAR(); GAPB(MFO(1,0,VFR(4)), C0,2); \
      WRD(1); SBAR(); GAPB(MFO(0,1,VFR(1)), C0,4); \
      WRD(5); SBAR(); GAPB(MFO(1,1,VFR(5)), C0,6); \
      WRD(2); SBAR(); GAPB(MFO(0,2,VFR(2)), C0,8); \
      WRD(6); SBAR(); GAPB(MFO(1,2,VFR(6)), C0,10); \
      WRD(3); SBAR(); GAPB(MFO(0,3,VFR(3)), C0,12); \
      WRD(7); SBAR(); GAPB(MFO(1,3,VFR(7)), C0,14); \
      KRD(GL,0); GAPB(MFO(2,0,WFR(0)), C1,0); KRD(GL,1); GAPB(MFO(3,0,WFR(4)), C1,2); KRD(GL,2); GAPB(MFO(2,1,WFR(1)), C1,4); KRD(GL,3); GAPB(MFO(3,1,WFR(5)), C1,6); \
      GAPB(MFO(2,2,WFR(2)), C1,8); GAPB(MFO(3,2,WFR(6)), C1,10); GAPB(MFO(2,3,WFR(3)), C1,12); GAPB(MFO(3,3,WFR(7)), C1,14); }while(0)
    #define RESC() do{ if(resc){ asm volatile("s_waitcnt lgkmcnt(0)":::"memory"); \
      _Pragma("unroll") for(int r=0;r<16;++r){ const float fr_=wsf[crow(r,hi)]; _Pragma("unroll") for(int d_=0;d_<4;++d_) o[d_][r]*=fr_; } } }while(0)
    #define STEP(C0,C1,P0,P1,t) do{ if((t)+3<=NT){WAIT_BAR(3);}else{WAIT_BAR(2);} \
      if((t)+3<NT){DMA_K((t)+3,sl_cur);} if((t)+1<NT){DMA_V((t)+1,sl_next);} \
      PHASEA(C0,C1,P0,P1); PHASEB(C0,C1,((t)+1<NT)); RESC(); ROT(); }while(0)
    int t=1;
    if(wid>=4)__builtin_amdgcn_s_setprio(1);
    #pragma unroll 1
    for(;t+1<NT;t+=2){ STEP(pB0,pB1,pA0,pA1,t); STEP(pA0,pA1,pB0,pB1,t+1); }
    STEP(pB0,pB1,pA0,pA1,NT-1);
    __builtin_amdgcn_s_setprio(0);
    WAIT_BAR(0);
    { float sacc=pB0[0]+pB0[1];
      #pragma unroll
      for(int r=2;r<16;++r)sacc+=pB0[r];
      #pragma unroll
      for(int r=0;r<16;++r)sacc+=pB1[r];
      l_reg+=sacc;
      pw0=(u32x4){PKW(pB0,0),PKW(pB0,2),PKW(pB0,4),PKW(pB0,6)};pw1=(u32x4){PKW(pB0,8),PKW(pB0,10),PKW(pB0,12),PKW(pB0,14)};pw2=(u32x4){PKW(pB1,0),PKW(pB1,2),PKW(pB1,4),PKW(pB1,6)};pw3=(u32x4){PKW(pB1,8),PKW(pB1,10),PKW(pB1,12),PKW(pB1,14)};
      SBAR(); const int vbl=(int)(lds0+U_LVLO)+((lane>>4)&1)*32+(lane&3)*8+(4*hi+((lane&15)>>2))*64+sl_prev;
      pv(o,vbl,PAF(0),PAF(1),PAF(2),PAF(3)); pv(o+2,vbl+(U_LVHI-U_LVLO),PAF(0),PAF(1),PAF(2),PAF(3)); }
    #undef DMA_K
    #undef DMA_V
    #undef ROT
    #undef MX3
    #undef ROWMAX
    #undef EXS
    #undef PKW
    #undef PAF
    #undef VFR
    #undef WFR
    #undef PIN
    #undef GAPA
    #undef GAPB
    #undef VRD
    #undef WRD
    #undef MFQ
    #undef MFO
    #undef PHASEA
    #undef PHASEB
    #undef KRD
    #undef RESC
    #undef STEP
    {auto rr=__builtin_amdgcn_permlane32_swap(__float_as_uint(l_reg),__float_as_uint(l_reg),false,false);l_reg=__uint_as_float(rr[0])+__uint_as_float(rr[1]);}
    int le_=lane; asm volatile("":"+v"(le_)); const int r32e=le_&31, hie=le_>>5;
    if(hie==0)wsf[32+r32e]=l_reg; asm volatile("s_waitcnt lgkmcnt(0)":::"memory");
    if(sid==0){
      #pragma unroll
      for(int r=0;r<16;++r){const int orow=crow(r,hie); const float rl=__builtin_amdgcn_rcpf(wsf[32+orow]);
        #pragma unroll
        for(int d=0;d<4;++d)stg[orow*128+d*32+r32e]=__float2bfloat16(o[d][r]*rl);}
    } else {
      float gl_[4];
      #pragma unroll
      for(int d=0;d<4;++d)gl_[d]=gsub[32*d+r32e]*gscale;
      #pragma unroll
      for(int r=0;r<16;++r){const int orow=crow(r,hie); const float rl=__builtin_amdgcn_rcpf(wsf[32+orow]); float q=0.f;
        #pragma unroll
        for(int d=0;d<4;++d){const float v=__bfloat162float(stg[orow*128+d*32+r32e])-lam*(o[d][r]*rl); o[d][r]=v; q+=v*v;}
        q+=SWZX(q,1);q+=SWZX(q,2);q+=SWZX(q,4);q+=SWZX(q,8);q+=SWZX(q,16);
        const float rs=__builtin_amdgcn_rsqf(q*(1.0f/128.0f)+1e-6f);
        #pragma unroll
        for(int d=0;d<4;++d)stg[orow*128+d*32+r32e]=__float2bfloat16(o[d][r]*rs*gl_[d]);}
      asm volatile("s_waitcnt lgkmcnt(0)":::"memory");
      bf16*Ow=Ob+(long)(wid*QBLK)*pout;
      #pragma unroll
      for(int i=0;i<8;++i){const int row=i*4+(le_>>4),ch=le_&15; const u32x4 v=*(const u32x4*)(stg+row*128+ch*8); *(u32x4*)(Ow+(long)row*pout+ch*8)=v;}
    }
    asm volatile("s_waitcnt lgkmcnt(0)\n\ts_barrier":::"memory");
  }
}
#undef SBAR
#undef WAIT_BAR
}
constexpr int NWAVES = 8;
constexpr int SEQ = 8192, NBATCH = 2, M = NBATCH * SEQ, D = 1024, FF = 2816, NI0 = 2304, NI1 = 3072;
constexpr float RMS_EPS = 1e-6f, LAM_INIT = 0.35550906f;
constexpr size_t MiB = 1u << 20;
constexpr size_t WS_CTL = 0, CTL_ZERO_BYTES = 1 * MiB;
constexpr size_t WS_SS = 512 * 1024;
constexpr size_t WS_WIN0 = 2 * MiB, WS_WO0 = WS_WIN0 + (size_t)NI0 * D * 2, WS_WIN1 = WS_WO0 + (size_t)D * D * 2, WS_WO1 = WS_WIN1 + (size_t)NI1 * D * 2,
                 WS_WGU0 = WS_WO1 + (size_t)D * D * 2, WS_WGU1 = WS_WGU0 + (size_t)2 * FF * D * 2, WS_WD0 = WS_WGU1 + (size_t)2 * FF * D * 2,
                 WS_WD1 = WS_WD0 + (size_t)FF * D * 2, WS_WEND = WS_WD1 + (size_t)FF * D * 2;
static_assert(WS_WEND <= 50 * MiB, "weights");
constexpr size_t WS_TAB = 50 * MiB;
constexpr size_t WS_XB = 64 * MiB, WS_PROJ = 96 * MiB, WS_H = 96 * MiB, WS_OC = 192 * MiB, WS_O = 192 * MiB, WS_END = 256 * MiB;
constexpr int CW_TMO = 0, CW_CODE = 1, CW_BAR = 4096;
constexpr int RING_OFF = 0, RING_BYTES = 146432;
constexpr int LDSCTL_OFF = RING_BYTES, MISC_OFF = LDSCTL_OFF + 320;
constexpr int LDS_BYTES = 147456;

#define GAS __attribute__((address_space(1)))
#define LAS __attribute__((address_space(3)))
typedef unsigned short bf16;
typedef unsigned v4u __attribute__((ext_vector_type(4)));
typedef float f32x4 __attribute__((ext_vector_type(4)));
typedef short bf16x8 __attribute__((ext_vector_type(8)));
typedef GAS unsigned gu32;
typedef GAS unsigned long long gu64;
#define RLX_AGENT __ATOMIC_RELAXED, __HIP_MEMORY_SCOPE_AGENT
#define LDS_WAIT() asm volatile("s_waitcnt lgkmcnt(0)" ::: "memory")
#define VM_WAIT() asm volatile("s_waitcnt vmcnt(0)" ::: "memory")
__device__ __forceinline__ unsigned long long rt() { return __builtin_amdgcn_s_memrealtime(); }
__device__ __forceinline__ unsigned f2bf(float f) { unsigned u = __builtin_bit_cast(unsigned, f); return (u + 0x7fffu + ((u >> 16) & 1u)) >> 16; }
__device__ __forceinline__ unsigned pk2(float lo, float hi) { return f2bf(lo) | (f2bf(hi) << 16); }

#define XB_TMO      128
#define XB_XCNT(j)  (256  + 64 * (j))
#define XB_XSUB(j)  (1280 + 64 * (j))
#define XB_XGEN(j)  (2304 + 64 * (j))
#define XB_TOP      3328
#define XB_TOPGEN   3392
#define XCD_BAR_WORDS 3456
#define XB_SPIN_CAP (1u << 18)

__device__ __forceinline__ unsigned xb_ld(unsigned* p)              { return __hip_atomic_load(p, __ATOMIC_RELAXED, __HIP_MEMORY_SCOPE_AGENT); }
__device__ __forceinline__ unsigned xb_add(unsigned* p, unsigned v) { return __hip_atomic_fetch_add(p, v, __ATOMIC_RELAXED, __HIP_MEMORY_SCOPE_AGENT); }
__device__ __forceinline__ unsigned xb_xcc_id() { return (unsigned)__builtin_amdgcn_s_getreg((3 << 11) | 20) & 0xFu; }
#define XB_SPIN(cond, bar) do { unsigned _sp = 0; while (cond) { __builtin_amdgcn_s_sleep(1); \
    if ((++_sp & 255u) == 0u) { if (xb_ld(&(bar)[XB_TMO])) break; if (_sp > XB_SPIN_CAP) { atomicAdd(&(bar)[XB_TMO], 1u); break; } } } } while (0)

struct XcdBarrier {
    unsigned* bar; unsigned x;
    volatile LAS unsigned* st;
};

__device__ __forceinline__ XcdBarrier xcd_barrier_post(unsigned* bar, volatile LAS unsigned* st) {
    XcdBarrier b; b.bar = bar; b.x = xb_xcc_id(); b.st = st;
    if (threadIdx.x == 0) (void)xb_add(&bar[XB_XCNT(b.x)], 1u);
    return b;
}
__device__ __forceinline__ void xcd_barrier_complete(unsigned* bar, unsigned x, unsigned& nloc, unsigned& nx) {
    const unsigned G = gridDim.x * gridDim.y * gridDim.z;
    unsigned sum, cnt, mine, sp = 0u;
    for (;;) {
        sum = 0u; cnt = 0u; mine = 0u;
#pragma unroll
        for (unsigned j = 0; j < 16; ++j) { const unsigned c = xb_ld(&bar[XB_XCNT(j)]); sum += c; cnt += (c > 0u) ? 1u : 0u; mine = (j == x) ? c : mine; }
        if (sum == G) break;
        __builtin_amdgcn_s_sleep(1);
        if ((++sp & 255u) == 0u) { if (xb_ld(&bar[XB_TMO])) break; if (sp > XB_SPIN_CAP) { atomicAdd(&bar[XB_TMO], 1u); break; } }
    }
    nloc = mine > 0u ? mine : 1u; nx = cnt > 0u ? cnt : 1u;
}

__device__ __forceinline__ void xcd_barrier(const XcdBarrier& b) {
    asm volatile("s_waitcnt vmcnt(0)" ::: "memory");
    __syncthreads();
    if (threadIdx.x == 0) {
        unsigned* bar = b.bar;
        __builtin_amdgcn_s_waitcnt(0);
        unsigned nloc = b.st[0], nx = b.st[1];
        if (nloc == 0u) { xcd_barrier_complete(bar, b.x, nloc, nx); b.st[0] = nloc; b.st[1] = nx; }
        const unsigned old = xb_add(&bar[XB_XSUB(b.x)], 1u);
        const unsigned gen = old / nloc;
        if (old + 1u == (gen + 1u) * nloc) {
            __builtin_amdgcn_fence(__ATOMIC_RELEASE, "agent");
            asm volatile("s_waitcnt vmcnt(0)" ::: "memory");
            const unsigned og = xb_add(&bar[XB_TOP], 1u);
            const unsigned tg = og / nx;
            if (og + 1u == (tg + 1u) * nx) xb_add(&bar[XB_TOPGEN], 1u);
            else XB_SPIN(xb_ld(&bar[XB_TOPGEN]) == tg, bar);
            __builtin_amdgcn_fence(__ATOMIC_ACQUIRE, "agent");
            xb_add(&bar[XB_XGEN(b.x)], 1u);
            asm volatile("s_waitcnt vmcnt(0)" ::: "memory");
        } else {
            XB_SPIN(xb_ld(&bar[XB_XGEN(b.x)]) == gen, bar);
            __builtin_amdgcn_fence(__ATOMIC_ACQUIRE, "agent");
            asm volatile("s_waitcnt vmcnt(0)" ::: "memory");
        }
    }
    __syncthreads();
}
struct Frame {
    LAS unsigned char* lds;
    volatile LAS unsigned* MISC;
    gu32* ctl;
    int tid, lane, wave;
    int vcu, G;
    const float* in[18]; float* out; unsigned char* ws;
};
__device__ __forceinline__ float wave_sum(float v) {
#pragma unroll
    for (int o = 1; o < 64; o <<= 1) v += __shfl_xor(v, o);
    return v;
}
__device__ __forceinline__ float bf2f(unsigned b) { return __uint_as_float(b << 16); }
__device__ __forceinline__ void p0_transpose_item(const float* W, const float* gain, int K, int N, bf16* WT, int kb, int nb, int dst_row0, LAS float* scr, int lane) {
    const int k0 = 64 * kb, n0 = 32 * nb;
    float wv[32];
#pragma unroll
    for (int i = 0; i < 32; ++i) wv[i] = W[(size_t)(k0 + 2 * i + (lane >> 5)) * N + n0 + (lane & 31)];
#pragma unroll
    for (int i = 0; i < 32; ++i) { const int kk = 2 * i + (lane >> 5); float w = wv[i]; if (gain) w *= gain[k0 + kk]; scr[kk * 33 + (lane & 31)] = w; }
    LDS_WAIT(); asm volatile("" ::: "memory");
    const int c = lane & 7;
#pragma unroll
    for (int j = 0; j < 4; ++j) { const int n = (lane >> 3) + 8 * j; const LAS float* s = scr + (8 * c) * 33 + n;
        v4u o; o.x = pk2(s[0 * 33], s[1 * 33]); o.y = pk2(s[2 * 33], s[3 * 33]); o.z = pk2(s[4 * 33], s[5 * 33]); o.w = pk2(s[6 * 33], s[7 * 33]);
        *(GAS v4u*)(WT + (size_t)(dst_row0 + n) * K + k0 + 8 * c) = o; }
    LDS_WAIT(); asm volatile("" ::: "memory");
}
__device__ __forceinline__ void cvt_rows(Frame& F, const float* src, bf16* XB, float* ss) {
    const int gw = F.vcu * NWAVES + F.wave, NGW = F.G * NWAVES;
    for (int m0 = gw; m0 < M; m0 += 2 * NGW) {
        const int m1 = m0 + NGW; const bool two = m1 < M;
        const GAS f32x4* xr0 = (const GAS f32x4*)(src + (size_t)m0 * D) + F.lane; const GAS f32x4* xr1 = (const GAS f32x4*)(src + (size_t)(two ? m1 : m0) * D) + F.lane;
        f32x4 v[4], w[4]; float s = 0.f, s2 = 0.f;
#pragma unroll
        for (int j = 0; j < 4; ++j) { v[j] = xr0[64 * j]; w[j] = xr1[64 * j]; }
#pragma unroll
        for (int j = 0; j < 4; ++j) { s += (v[j].x * v[j].x + v[j].y * v[j].y) + (v[j].z * v[j].z + v[j].w * v[j].w); s2 += (w[j].x * w[j].x + w[j].y * w[j].y) + (w[j].z * w[j].z + w[j].w * w[j].w); }
        s = wave_sum(s); s2 = wave_sum(s2);
        GAS unsigned long long* o0 = (GAS unsigned long long*)(XB + (size_t)m0 * D) + F.lane;
#pragma unroll
        for (int j = 0; j < 4; ++j) o0[64 * j] = (unsigned long long)pk2(v[j].x, v[j].y) | ((unsigned long long)pk2(v[j].z, v[j].w) << 32);
        if (F.lane == 0) ss[m0] = s;
        if (two) { GAS unsigned long long* o1 = (GAS unsigned long long*)(XB + (size_t)m1 * D) + F.lane;
#pragma unroll
            for (int j = 0; j < 4; ++j) o1[64 * j] = (unsigned long long)pk2(w[j].x, w[j].y) | ((unsigned long long)pk2(w[j].z, w[j].w) << 32);
            if (F.lane == 0) ss[m1] = s2; }
    }
}
__device__ __forceinline__ void p0_prologue(Frame& F) {
    LAS float* scr = (LAS float*)(F.lds + RING_OFF + F.wave * 16384);
    const int gw = F.vcu * NWAVES + F.wave, NGW = F.G * NWAVES;
    constexpr int I_IN0 = 16 * (NI0 / 32), I_O = 16 * (D / 32), I_IN1 = 16 * (NI1 / 32), I_G = 16 * (FF / 32), I_D = (FF / 64) * (D / 32);
    constexpr int NITEMS = I_IN0 + I_O + I_IN1 + I_O + 2 * (2 * I_G + I_D);
    const float* attn_norm = F.in[1]; const float* ffn_norm = F.in[2];
    for (int it = gw; it < NITEMS; it += NGW) {
        int r = it;
        if (r < I_IN0) { const int nbk = NI0 / 32; const int n0 = 32 * (r % nbk), c = n0 & 255; p0_transpose_item(F.in[4], attn_norm, D, NI0, (bf16*)(F.ws + WS_WIN0), r / nbk, r % nbk, (n0 & ~255) + 128 * ((c & 63) >> 5) + 32 * (c >> 6), scr, F.lane); continue; } r -= I_IN0;
        if (r < I_O) { const int nbk = D / 32; p0_transpose_item(F.in[7], nullptr, D, D, (bf16*)(F.ws + WS_WO0), r / nbk, r % nbk, 32 * (r % nbk), scr, F.lane); continue; } r -= I_O;
        if (r < I_IN1) { const int nbk = NI1 / 32; const int n0 = 32 * (r % nbk), c = n0 & 255; p0_transpose_item(F.in[8], attn_norm + D, D, NI1, (bf16*)(F.ws + WS_WIN1), r / nbk, r % nbk, (n0 & ~255) + 128 * ((c & 63) >> 5) + 32 * (c >> 6), scr, F.lane); continue; } r -= I_IN1;
        if (r < I_O) { const int nbk = D / 32; p0_transpose_item(F.in[14], nullptr, D, D, (bf16*)(F.ws + WS_WO1), r / nbk, r % nbk, 32 * (r % nbk), scr, F.lane); continue; } r -= I_O;
        const int l = r / (2 * I_G + I_D); r -= l * (2 * I_G + I_D);
        if (r < 2 * I_G) { const int up = r / I_G; r -= up * I_G; const int nbk = FF / 32, nb = r % nbk, n0 = 32 * nb;
            p0_transpose_item((up ? F.in[16] : F.in[15]) + (size_t)l * D * FF, ffn_norm + l * D, D, FF, (bf16*)(F.ws + (l ? WS_WGU1 : WS_WGU0)), r / nbk, nb, (n0 / 128) * 256 + (n0 % 128) + up * 128, scr, F.lane); continue; }
        r -= 2 * I_G;
        { const int nbk = D / 32; p0_transpose_item(F.in[17] + (size_t)l * FF * D, nullptr, FF, D, (bf16*)(F.ws + (l ? WS_WD1 : WS_WD0)), r / nbk, r % nbk, 32 * (r % nbk), scr, F.lane); }
    }
    { float* tab = (float*)(F.ws + WS_TAB); const int gt = (F.vcu * NWAVES + F.wave) * 64 + F.lane, NGT = F.G * NWAVES * 64;
      for (int idx = gt; idx < SEQ * 32; idx += NGT) { const int t = idx >> 5, i = idx & 31;
          const float a1 = (float)t * powf(10000.f, -(float)(2 * i) / 64.f);
          const float a2 = (float)(i < 16 ? (t >> 6) : (t & 63)) * powf(10000.f, -(float)(2 * (i & 15)) / 32.f);
          float s1, c1, s2, c2; sincosf(a1, &s1, &c1); sincosf(a2, &s2, &c2);
          tab[idx] = c1; tab[SEQ * 32 + idx] = s1; tab[2 * SEQ * 32 + idx] = c2; tab[3 * SEQ * 32 + idx] = s2; } }
    cvt_rows(F, F.in[0], (bf16*)(F.ws + WS_XB), (float*)(F.ws + WS_SS));
}
template <int LAYER> __device__ __forceinline__ void rope_phase(Frame& F) {
    constexpr int pitch = LAYER == 0 ? NI0 : NI1, NIT = LAYER == 0 ? 9 : 8;
    const float* tab = (const float*)(F.ws + WS_TAB);
    const float* qn = F.in[5]; const float* kn = F.in[6];
    bf16* P = (bf16*)(F.ws + WS_PROJ);
    const int gw = F.vcu * NWAVES + F.wave, NGW = F.G * NWAVES;
    const int sub = F.lane >> 4, d0 = (F.lane & 15) * 4, i0 = d0 & 31;
    f32x4 gq = (f32x4){1.f, 1.f, 1.f, 1.f}, gk = gq;
    if (LAYER == 0) { gq = *(const f32x4*)(qn + d0); gk = *(const f32x4*)(kn + d0); }
    for (int row = gw; row < M; row += NGW) {
        const int t = row & (SEQ - 1);
        const f32x4 c1 = *(const f32x4*)(tab + t * 32 + i0), s1 = *(const f32x4*)(tab + SEQ * 32 + t * 32 + i0);
        f32x4 c2 = c1, s2 = s1;
        if (LAYER == 0) { c2 = *(const f32x4*)(tab + 2 * SEQ * 32 + t * 32 + i0); s2 = *(const f32x4*)(tab + 3 * SEQ * 32 + t * 32 + i0); }
        bf16* prow = P + (size_t)row * pitch;
#pragma unroll
        for (int it = 0; it < NIT; ++it) {
            const int head = it * 4 + sub;
            int mode; float scale = 1.f;
            if (LAYER == 0) { mode = head < 8 ? 2 : head < 10 ? 3 : head < 12 ? 0 : head < 28 ? 1 : 0; if (head < 8 || (head >= 12 && head < 20)) scale = attn_body::C2; }
            else { mode = 1; if (head < 16) scale = attn_body::C2; }
            GAS unsigned long long* pp = (GAS unsigned long long*)(prow + head * 64 + d0);
            const unsigned long long raw = *pp;
            f32x4 y = (f32x4){bf2f((unsigned)raw & 0xffffu), bf2f(((unsigned)raw >> 16) & 0xffffu), bf2f((unsigned)(raw >> 32) & 0xffffu), bf2f((unsigned)(raw >> 48) & 0xffffu)};
            if (LAYER == 0) { float q = (y.x * y.x + y.y * y.y) + (y.z * y.z + y.w * y.w);
                q += __shfl_xor(q, 1); q += __shfl_xor(q, 2); q += __shfl_xor(q, 4); q += __shfl_xor(q, 8);
                const float r = rsqrtf(q * (1.f / 64.f) + RMS_EPS);
                if (mode == 2) y = y * r * gq; else if (mode == 3) y = y * r * gk; }
            const f32x4 c = (mode == 1) ? c1 : c2, s = (mode == 1) ? s1 : s2;
            f32x4 o; o.x = __shfl_xor(y.x, 8); o.y = __shfl_xor(y.y, 8); o.z = __shfl_xor(y.z, 8); o.w = __shfl_xor(y.w, 8);
            const f32x4 res = ((d0 < 32) ? (y * c - o * s) : (o * s + y * c)) * scale;
            if (mode) *pp = (unsigned long long)pk2(res.x, res.y) | ((unsigned long long)pk2(res.z, res.w) << 32);
        }
    }
}
__device__ __forceinline__ void combine_phase(Frame& F) {
    const int gw = F.vcu * NWAVES + F.wave, NGW = F.G * NWAVES;
    const float sa = wave_sum(F.in[9][F.lane] * F.in[10][F.lane]), sb = wave_sum(F.in[11][F.lane] * F.in[12][F.lane]);
    const float lam = expf(sa) - expf(sb) + LAM_INIT;
    const float* gs = F.in[13] + (F.lane & 7) * 16;
    const f32x4 g0 = *(const f32x4*)(gs), g1 = *(const f32x4*)(gs + 4), g2 = *(const f32x4*)(gs + 8), g3 = *(const f32x4*)(gs + 12);
    const bf16* O2 = (const bf16*)(F.ws + WS_O); bf16* OC = (bf16*)(F.ws + WS_OC);
    for (int row = gw; row < M; row += NGW) {
        const GAS v4u* p1 = (const GAS v4u*)(O2 + (size_t)row * 2048 + F.lane * 16); const GAS v4u* p2 = (const GAS v4u*)(O2 + (size_t)row * 2048 + 1024 + F.lane * 16);
        const v4u a0 = p1[0], a1 = p1[1], b0 = p2[0], b1 = p2[1];
        float o[16];
#pragma unroll
        for (int j = 0; j < 4; ++j) { o[2 * j] = bf2f(a0[j] & 0xffffu) - lam * bf2f(b0[j] & 0xffffu); o[2 * j + 1] = bf2f(a0[j] >> 16) - lam * bf2f(b0[j] >> 16);
                                      o[8 + 2 * j] = bf2f(a1[j] & 0xffffu) - lam * bf2f(b1[j] & 0xffffu); o[8 + 2 * j + 1] = bf2f(a1[j] >> 16) - lam * bf2f(b1[j] >> 16); }
        float q = 0.f;
#pragma unroll
        for (int j = 0; j < 16; ++j) q += o[j] * o[j];
        q += __shfl_xor(q, 1); q += __shfl_xor(q, 2); q += __shfl_xor(q, 4);
        const float r = rsqrtf(q * (1.f / 128.f) + RMS_EPS) * (1.0f - LAM_INIT);
        v4u w0, w1;
        w0.x = pk2(o[0] * r * g0.x, o[1] * r * g0.y); w0.y = pk2(o[2] * r * g0.z, o[3] * r * g0.w); w0.z = pk2(o[4] * r * g1.x, o[5] * r * g1.y); w0.w = pk2(o[6] * r * g1.z, o[7] * r * g1.w);
        w1.x = pk2(o[8] * r * g2.x, o[9] * r * g2.y); w1.y = pk2(o[10] * r * g2.z, o[11] * r * g2.w); w1.z = pk2(o[12] * r * g3.x, o[13] * r * g3.y); w1.w = pk2(o[14] * r * g3.z, o[15] * r * g3.w);
        GAS v4u* po = (GAS v4u*)(OC + (size_t)row * 1024 + F.lane * 16); po[0] = w0; po[1] = w1;
    }
}
__device__ __forceinline__ void final_norm_phase(Frame& F) {
    const int gw = F.vcu * NWAVES + F.wave, NGW = F.G * NWAVES;
    const float* ss = (const float*)(F.ws + WS_SS) + 4 * M; const GAS f32x4* g = (const GAS f32x4*)F.in[3] + F.lane;
    for (int m = gw; m < M; m += NGW) {
        const float r = rsqrtf(ss[m] * (1.f / 1024.f) + RMS_EPS);
        GAS f32x4* xr = (GAS f32x4*)(F.out + (size_t)m * D) + F.lane;
#pragma unroll
        for (int j = 0; j < 4; ++j) xr[64 * j] = xr[64 * j] * r * g[64 * j];
    }
}
template <int LAYER> __device__ __forceinline__ void attention_phase(Frame& F, char* lds) {
    using abf = attn_body::bf16;
    const abf* P = (const abf*)(F.ws + WS_PROJ); abf* O = (abf*)(F.ws + WS_O);
    if (LAYER == 0) {
        LAS float* tb = (LAS float*)(F.lds + attn_body::DTBL_OFF);
        for (int idx = F.tid; idx < attn_body::DTBL_N; idx += NWAVES * 64) { const int off = idx - 1280, ao = off < 0 ? -off : off;
            const int mm = (ao <= 64 ? 1 : 0) + ((((off & 3) == 0) && ao <= 256) ? 1 : 0) + ((((off & 15) == 0) && ao <= 1024) ? 1 : 0);
            tb[idx] = mm == 0 ? -1000.f : (mm == 1 ? 0.f : (mm == 2 ? 1.f : 1.5849625007f)); }
        __syncthreads();
        for (int i = 0;; ++i) { const int U = i * F.G + F.vcu; if (U >= 1024) break;
            const int ii = U >> 8, v = U & 255, bh = v >> 4, s = v & 15, b = bh >> 3, h = bh & 7, qb = (ii & 1) ? 31 - s : s, q0 = qb * 256; const size_t rowb = (size_t)b * SEQ;
            if (ii < 2) attn_body::attn_unit<8, 0>(P + (rowb + q0) * NI0 + h * 64, P + rowb * NI0 + 512 + (h >> 2) * 64, P + rowb * NI0 + 640 + (h >> 2) * 64, O + (rowb + q0) * 1024 + h * 64, NI0, 1024, 128, 0, lds);
            else { const int tlo = (q0 - 1024 < 0 ? 0 : q0 - 1024) / 64, thi = (q0 + 1280 > SEQ ? SEQ : q0 + 1280) / 64;
                attn_body::attn_unit<8, 1>(P + (rowb + q0) * NI0 + 768 + h * 64, P + (rowb + 64 * tlo) * NI0 + 1280 + h * 64, P + (rowb + 64 * tlo) * NI0 + 1792 + h * 64, O + (rowb + q0) * 1024 + 512 + h * 64, NI0, 1024, thi - tlo, 64 * tlo - q0, lds); } }
    } else {
        static_assert(attn_body::U_LDS_BYTES <= RING_BYTES, "diff-attention unit LDS");
        float sa = 0.f, sb = 0.f;
        for (int i = 0; i < 64; ++i) { sa += F.in[9][i] * F.in[10][i]; sb += F.in[11][i] * F.in[12][i]; }
        const float lam = expf(sa) - expf(sb) + LAM_INIT;
        for (int i = 0;; ++i) { const int U = i * F.G + F.vcu; if (U >= 512) break;
            const int ii = U >> 8, v = U & 255, bh = v >> 4, b = bh >> 3, h = bh & 7, qb = (v & 15) + 16 * ii, q0 = qb * 256; const size_t rowb = (size_t)b * SEQ;
            attn_body::attn_unit128p<8>(P + (rowb + q0) * NI1 + h * 128, P + rowb * NI1 + 1024 + h * 128, P + rowb * NI1 + 2048 + h * 128,
                                       O + (rowb + q0) * 1024 + h * 128, NI1, 1024, 128, lam, F.in[13], 1.0f - LAM_INIT, lds); }
    }
}

struct Args { const float* in[18]; float* out; unsigned char* ws; int ph_lo, ph_hi, li, cvt_ss; };
__global__ void __launch_bounds__(NWAVES * 64, 2) mk_fwd(Args args) {
    extern __shared__ __attribute__((aligned(16))) unsigned char lds[];
    Frame F;
    F.lds = (LAS unsigned char*)lds;
    F.MISC = (volatile LAS unsigned*)(F.lds + MISC_OFF);
    F.tid = threadIdx.x; F.lane = F.tid & 63; F.wave = __builtin_amdgcn_readfirstlane(F.tid >> 6);
    F.G = gridDim.x; { const int bx = blockIdx.x; F.vcu = (F.G % 8 == 0) ? (bx % 8) * (F.G / 8) + bx / 8 : bx; }
    unsigned char* ws = args.ws; F.ws = ws; F.out = args.out;
#pragma unroll
    for (int i = 0; i < 18; ++i) F.in[i] = args.in[i];
    F.ctl = (gu32*)(ws + WS_CTL);
    for (int u = F.tid; u < (LDS_BYTES - LDSCTL_OFF) / 4; u += NWAVES * 64) ((LAS unsigned*)(F.lds + LDSCTL_OFF))[u] = 0u;
    __syncthreads();
    XcdBarrier bar = xcd_barrier_post((unsigned*)(F.ctl + CW_BAR) + args.li * XCD_BAR_WORDS, F.MISC + 8);
    const int lo = args.ph_lo, hi = args.ph_hi;
#define IN(k) (lo <= (k) && (k) < hi)
#define SEAM(k) do { if (IN(k) && IN((k) + 1)) xcd_barrier(bar); } while (0)
    float* ss = (float*)(ws + WS_SS);
    bf16* XB = (bf16*)(ws + WS_XB); bf16* PROJ = (bf16*)(ws + WS_PROJ); bf16* HB = (bf16*)(ws + WS_H); bf16* OC = (bf16*)(ws + WS_OC); bf16* OB = (bf16*)(ws + WS_O);
    if (IN(0)) { p0_prologue(F); SEAM(0); }
#define LAYER_BODY(l) do { \
        const int pb = 1 + 7 * l; \
        if (IN(pb + 0)) { const int N = l ? NI1 : NI0; \
            pg8::Gemm g{XB, (const bf16*)(ws + (l ? WS_WIN1 : WS_WIN0)), M, N, D}; pg8::StaticOrder S; S.init(M, N, F.G, (int)blockIdx.x); \
            if (l == 0) { pg8::EpiProjRope<0> E{PROJ, N, ss + (size_t)(2 * l) * M, (const float*)(ws + WS_TAB), F.in[5], F.in[6], attn_body::C2}; \
                pg8::gemm_phase<pg8::EpiProjRope<0>, pg8::StaticOrder, PG8_ALIGN, PG8_SP2>(F.lds + RING_OFF, g, S, E); } \
            else { pg8::EpiProjRope<1> E{PROJ, N, ss + (size_t)(2 * l) * M, (const float*)(ws + WS_TAB), F.in[5], F.in[6], attn_body::C2}; \
                pg8::gemm_phase<pg8::EpiProjRope<1>, pg8::StaticOrder, PG8_ALIGN, PG8_SP2>(F.lds + RING_OFF, g, S, E); } \
            if (IN(pb + 2)) xcd_barrier(bar); } \
        if (IN(pb + 2)) { if (l == 0) attention_phase<0>(F, (char*)lds + RING_OFF); else attention_phase<1>(F, (char*)lds + RING_OFF); if (IN(pb + 4)) xcd_barrier(bar); } \
          \
        if (IN(pb + 4)) { pg8::Gemm g{l ? OC : OB, (const bf16*)(ws + (l ? WS_WO1 : WS_WO0)), M, D, D}; pg8::StaticOrder S; S.init(M, D, F.G, (int)blockIdx.x); \
            pg8::EpiResid E{l ? (const float*)F.out : F.in[0], F.out, XB, ss + (size_t)(2 * l + 1) * M}; \
            pg8::gemm_phase<pg8::EpiResid, pg8::StaticOrder, PG8_ALIGN, PG8_SP2>(F.lds + RING_OFF, g, S, E); SEAM(pb + 4); } \
        if (IN(pb + 5)) { pg8::Gemm g{XB, (const bf16*)(ws + (l ? WS_WGU1 : WS_WGU0)), M, 2 * FF, D}; pg8::StaticOrder S; S.init(M, 2 * FF, F.G, (int)blockIdx.x); \
            pg8::EpiSwiGLU E{HB, FF, ss + (size_t)(2 * l + 1) * M}; \
            pg8::gemm_phase<pg8::EpiSwiGLU, pg8::StaticOrder, PG8_ALIGN, PG8_SP2>(F.lds + RING_OFF, g, S, E); SEAM(pb + 5); } \
        if (IN(pb + 6)) { pg8::Gemm g{HB, (const bf16*)(ws + (l ? WS_WD1 : WS_WD0)), M, D, FF}; pg8::StaticOrder S; S.init(M, D, F.G, (int)blockIdx.x); \
            pg8::EpiResid E{F.out, F.out, XB, ss + (size_t)(2 * l + 2) * M}; \
            pg8::gemm_phase<pg8::EpiResid, pg8::StaticOrder, PG8_ALIGN, PG8_SP2>(F.lds + RING_OFF, g, S, E); SEAM(pb + 6); } \
    } while (0)
    LAYER_BODY(0);
    LAYER_BODY(1);
#undef LAYER_BODY
    if (IN(15)) final_norm_phase(F);
    if (IN(16)) cvt_rows(F, F.out, XB, ss + (size_t)args.cvt_ss * M);
#undef IN
#undef SEAM
}

static int g_grid = 0;
static int g_li = 0;
static void fast_seg(void* const* d_in, void* d_out, void* d_ws, hipStream_t stream, int lo, int hi, int cvt_ss = 0) {
    Args a{};
    for (int i = 0; i < 18; ++i) a.in[i] = (const float*)d_in[i];
    a.out = (float*)d_out; a.ws = (unsigned char*)d_ws; a.ph_lo = lo; a.ph_hi = hi; a.li = g_li++; a.cvt_ss = cvt_ss;
    hipLaunchKernelGGL(mk_fwd, dim3(g_grid), dim3(NWAVES * 64), LDS_BYTES, stream, a);
}
extern "C" void kernel_launch(void* const* d_in, const int* in_sizes, int n_in, void* d_out, int out_size, void* d_ws, size_t ws_size, hipStream_t stream) {
    if (g_grid == 0) {
        if (n_in != 18 || in_sizes[0] != M * D || out_size != M * D || ws_size < WS_END) { fprintf(stderr, "kernel_launch: unexpected shapes (n_in %d, ws %zu)\n", n_in, ws_size); g_grid = -1; return; }
        int dev = 0, cus = 0, per_cu = 0;
        if (hipGetDevice(&dev) != hipSuccess || hipDeviceGetAttribute(&cus, hipDeviceAttributeMultiprocessorCount, dev) != hipSuccess) { g_grid = -1; return; }
        if (hipFuncSetAttribute((const void*)mk_fwd, hipFuncAttributeMaxDynamicSharedMemorySize, LDS_BYTES) != hipSuccess) { fprintf(stderr, "kernel_launch: hipFuncSetAttribute failed\n"); g_grid = -1; return; }
        if (hipOccupancyMaxActiveBlocksPerMultiprocessor(&per_cu, (const void*)mk_fwd, NWAVES * 64, LDS_BYTES) != hipSuccess || per_cu < 1) fprintf(stderr, "kernel_launch: occupancy query reports %d\n", per_cu);
        (void)hipGetLastError();
        g_grid = cus;
    }
    if (g_grid < 0) return;
    g_li = 0;
    hipMemsetAsync((char*)d_ws + WS_CTL, 0, CTL_ZERO_BYTES, stream);
    fast_seg(d_in, d_out, d_ws, stream, 0, 16);

}
```
